# Optimizing an MI355X kernel written in HIP

```python
import math
import numpy as np
import jax
import jax.numpy as jnp
from jax import lax

D_MODEL = 1024
BATCH = 2
SEQ = 16384
DEPTH = 2

MEM_LEN = 256
NORM_EPS = 1e-6
ROPE_THETA = 10000.0
NEG_INF = -1e30
FORCE_SCORE = 1e9

NSA_HEADS = 8
NSA_KV_GROUPS = 2
NSA_HEAD_DIM = 64
NSA_CMP_BLOCK = 32
NSA_CMP_STRIDE = 16
NSA_SEL_BLOCK = 64
NSA_TOPK = 16
NSA_WINDOW = 512
NSA_Q_BLOCK = 128
NSA_Q_WIDTH = NSA_HEADS * NSA_HEAD_DIM
NSA_KV_WIDTH = NSA_KV_GROUPS * NSA_HEAD_DIM

SSM_INNER = 512
SSM_HEAD_DIM = 64
SSM_HEADS = SSM_INNER // SSM_HEAD_DIM
SSM_GROUPS = 2
SSM_STATE = 64
SSM_CONV = 4
SSM_CHUNK = 128
SSM_CONV_DIM = SSM_INNER + 2 * SSM_GROUPS * SSM_STATE
DT_MIN = 1e-3
DT_MAX = 1e-1

HG_HEADS = 4
HG_KEY_DIM = 128
HG_VAL_DIM = 128
HG_WIDTH = HG_HEADS * HG_KEY_DIM
HG_CHUNK = 64

XA_HEADS = 4
XA_HEAD_DIM = 128
XA_WIDTH = XA_HEADS * XA_HEAD_DIM

FFN_HIDDEN = -(-(8 * D_MODEL) // (3 * 256)) * 256

SPLIT_SIZES = (
    NSA_Q_WIDTH,
    NSA_KV_WIDTH, NSA_KV_WIDTH,
    NSA_KV_WIDTH, NSA_KV_WIDTH,
    NSA_KV_WIDTH, NSA_KV_WIDTH,
    3 * NSA_HEADS,
    SSM_INNER,
    SSM_CONV_DIM,
    SSM_HEADS,
    HG_WIDTH, HG_WIDTH,
    HG_HEADS * HG_VAL_DIM,
    HG_HEADS * HG_VAL_DIM,
    D_MODEL, D_MODEL, D_MODEL,
)
IN_DIM = sum(SPLIT_SIZES)

kernel_name = 'hybrid_nsa_ssd_hgrn2_decoder'


def rms_norm(x, w):
    xf = x.astype(jnp.float32)
    y = xf * lax.rsqrt(jnp.mean(xf * xf, axis=-1, keepdims=True) + NORM_EPS)
    return (y * w.astype(jnp.float32)).astype(x.dtype)


def rope(x, pos):
    half = x.shape[-1] // 2
    inv = 1.0 / (ROPE_THETA ** (jnp.arange(half, dtype=jnp.float32) / half))
    ang = pos.astype(jnp.float32)[:, None] * inv[None, :]
    cos = jnp.cos(ang)[:, None, :]
    sin = jnp.sin(ang)[:, None, :]
    xf = x.astype(jnp.float32)
    x1, x2 = xf[..., :half], xf[..., half:]
    return jnp.concatenate([x1 * cos - x2 * sin, x2 * cos + x1 * sin], axis=-1).astype(x.dtype)


def masked_softmax(s, mask):
    s = jnp.where(mask, s.astype(jnp.float32), NEG_INF)
    return jnp.where(mask, jax.nn.softmax(s, axis=-1), 0.0)


def compress_blocks(kv, pos_emb, w1, w2):
    bsz, s, g, hd = kv.shape
    nb = (s - NSA_CMP_BLOCK) // NSA_CMP_STRIDE + 1
    idx = jnp.arange(nb)[:, None] * NSA_CMP_STRIDE + jnp.arange(NSA_CMP_BLOCK)[None, :]
    blk = kv[:, idx] + pos_emb[None, None, :, None, :]
    blk = blk.transpose(0, 1, 3, 2, 4).reshape(bsz, nb, g, NSA_CMP_BLOCK * hd)
    return jax.nn.silu(blk @ w1) @ w2


def nsa_mixer(q, k_cmp, v_cmp, k_slc, v_slc, k_win, v_win, gate_logits, q_norm, k_norm,
              cmp_pos_k, cmp_pos_v, cmp_w1_k, cmp_w2_k, cmp_w1_v, cmp_w2_v):
    bsz, s, _ = q.shape
    H, G, hd = NSA_HEADS, NSA_KV_GROUPS, NSA_HEAD_DIM
    R = H // G
    Lc, stride, Ls, W, QB = NSA_CMP_BLOCK, NSA_CMP_STRIDE, NSA_SEL_BLOCK, NSA_WINDOW, NSA_Q_BLOCK
    scale = hd ** -0.5
    pos = jnp.arange(s)

    def heads(t, n):
        return t.reshape(bsz, s, n, hd)

    q = rope(rms_norm(heads(q, H), q_norm), pos).reshape(bsz, s, G, R, hd)
    ks = rope(rms_norm(heads(k_slc, G), k_norm), pos)
    kw = rope(rms_norm(heads(k_win, G), k_norm), pos)
    vs = heads(v_slc, G)
    vw = heads(v_win, G)

    nb = (s - Lc) // stride + 1
    pos_c = jnp.arange(nb) * stride + Lc - 1
    kc = rope(rms_norm(compress_blocks(heads(k_cmp, G), cmp_pos_k, cmp_w1_k, cmp_w2_k), k_norm), pos_c)
    vc = compress_blocks(heads(v_cmp, G), cmp_pos_v, cmp_w1_v, cmp_w2_v)

    nsel = s // Ls
    n_top = min(NSA_TOPK, nsel)
    ks_blk = ks.reshape(bsz, nsel, Ls, G, hd).transpose(0, 3, 1, 2, 4)
    vs_blk = vs.reshape(bsz, nsel, Ls, G, hd).transpose(0, 3, 1, 2, 4)
    c_start = jnp.arange(nb) * stride
    s_start = jnp.arange(nsel) * Ls
    cover = jnp.clip(jnp.minimum(c_start[:, None] + Lc, s_start[None, :] + Ls)
                     - jnp.maximum(c_start[:, None], s_start[None, :]), 0, None)
    w_cover = cover.astype(jnp.float32) / stride

    kw_pad = jnp.pad(kw, ((0, 0), (W, 0), (0, 0), (0, 0)))
    vw_pad = jnp.pad(vw, ((0, 0), (W, 0), (0, 0), (0, 0)))
    gates = jax.nn.sigmoid(gate_logits.astype(jnp.float32)).reshape(bsz, s, G, R, 3)
    b_idx = jnp.arange(bsz)[:, None, None, None]
    g_idx = jnp.arange(G)[None, :, None, None]
    blk_ids = jnp.arange(nsel)

    def block_fn(qb):
        start = qb * QB
        t = start + jnp.arange(QB)
        qblk = lax.dynamic_slice_in_dim(q, start, QB, axis=1)
        s_c = jnp.einsum('bqgrd,bngd->bgrqn', qblk, kc) * scale
        p_c = masked_softmax(s_c, pos_c[None, :] <= t[:, None])
        o_c = jnp.einsum('bgrqn,bngd->bqgrd', p_c, vc)
        imp = jnp.einsum('bgrqn,nj->bgqj', p_c, w_cover)
        cur = (t // Ls)[:, None]
        forced = (blk_ids[None, :] == 0) | (blk_ids[None, :] == cur) | (blk_ids[None, :] == cur - 1)
        valid = blk_ids[None, :] * Ls <= t[:, None]
        imp = jnp.where(forced, FORCE_SCORE, jnp.where(valid, imp, NEG_INF))
        _, sel = lax.top_k(imp, n_top)
        k_sel = ks_blk[b_idx, g_idx, sel]
        v_sel = vs_blk[b_idx, g_idx, sel]
        key_pos = sel[..., None] * Ls + jnp.arange(Ls)
        mask_s = (key_pos <= t[None, None, :, None, None]).reshape(bsz, G, 1, QB, n_top * Ls)
        s_s = jnp.einsum('bqgrd,bgqkld->bgrqkl', qblk, k_sel).reshape(bsz, G, R, QB, n_top * Ls) * scale
        p_s = masked_softmax(s_s, mask_s).reshape(bsz, G, R, QB, n_top, Ls)
        o_s = jnp.einsum('bgrqkl,bgqkld->bqgrd', p_s, v_sel)
        k_w = lax.dynamic_slice_in_dim(kw_pad, start, QB + W, axis=1)
        v_w = lax.dynamic_slice_in_dim(vw_pad, start, QB + W, axis=1)
        key_pos_w = start - W + jnp.arange(QB + W)
        dlt = t[:, None] - key_pos_w[None, :]
        mask_w = (dlt >= 0) & (dlt < W) & (key_pos_w[None, :] >= 0)
        s_w = jnp.einsum('bqgrd,bkgd->bgrqk', qblk, k_w) * scale
        p_w = masked_softmax(s_w, mask_w)
        o_w = jnp.einsum('bgrqk,bkgd->bqgrd', p_w, v_w)
        gt = lax.dynamic_slice_in_dim(gates, start, QB, axis=1)
        return gt[..., 0:1] * o_c + gt[..., 1:2] * o_s + gt[..., 2:3] * o_w

    out = lax.map(block_fn, jnp.arange(s // QB))
    return out.transpose(1, 0, 2, 3, 4, 5).reshape(bsz, s, H * hd)


def ssd_chunked(x, a, bm, cm):
    bsz, s, H, P = x.shape
    G, N = bm.shape[-2], bm.shape[-1]
    Hg, L = H // G, SSM_CHUNK
    nc = s // L
    x = x.reshape(bsz, nc, L, G, Hg, P)
    a = a.reshape(bsz, nc, L, G, Hg)
    bm = bm.reshape(bsz, nc, L, G, N)
    cm = cm.reshape(bsz, nc, L, G, N)
    a_cum = jnp.cumsum(a, axis=2)
    tri = jnp.tril(jnp.ones((L, L), dtype=bool))[None, None, :, :, None, None]
    seg = a_cum[:, :, :, None] - a_cum[:, :, None, :]
    decay = jnp.exp(jnp.where(tri, seg, NEG_INF))
    cb = jnp.einsum('bctgn,bcsgn->bctsg', cm, bm)
    y_diag = jnp.einsum('bctsgh,bcsghp->bctghp', cb[..., None] * decay, x)
    decay_end = jnp.exp(a_cum[:, :, -1:] - a_cum)
    states = jnp.einsum('bcsgn,bcsghp->bcghpn', bm, x * decay_end[..., None])
    chunk_decay = jnp.exp(a_cum[:, :, -1])

    def step(h, inp):
        st, dec = inp
        return h * dec[..., None, None] + st, h

    h0 = jnp.zeros((bsz, G, Hg, P, N), jnp.float32)
    _, prev = lax.scan(step, h0, (states.transpose(1, 0, 2, 3, 4, 5), chunk_decay.transpose(1, 0, 2, 3)))
    prev = prev.transpose(1, 0, 2, 3, 4, 5)
    y_off = jnp.einsum('bctgn,bcghpn->bctghp', cm, prev) * jnp.exp(a_cum)[..., None]
    return (y_diag + y_off).reshape(bsz, s, H, P)


def mamba2_mixer(z, xbc, dt_raw, conv_w, conv_b, dt_bias, a_log, d_skip, norm_w):
    bsz, s, _ = xbc.shape
    G, N = SSM_GROUPS, SSM_STATE
    xpad = jnp.pad(xbc, ((0, 0), (SSM_CONV - 1, 0), (0, 0)))
    conv = conv_b
    for k in range(SSM_CONV):
        conv = conv + xpad[:, k:k + s] * conv_w[k]
    xbc = jax.nn.silu(conv.astype(jnp.float32))
    xs = xbc[..., :SSM_INNER].reshape(bsz, s, SSM_HEADS, SSM_HEAD_DIM)
    bm = xbc[..., SSM_INNER:SSM_INNER + G * N].reshape(bsz, s, G, N)
    cm = xbc[..., SSM_INNER + G * N:].reshape(bsz, s, G, N)
    dt = jax.nn.softplus(dt_raw.astype(jnp.float32) + dt_bias)
    a = -jnp.exp(a_log.astype(jnp.float32))
    y = ssd_chunked(xs * dt[..., None], dt * a, bm, cm) + xs * d_skip[:, None]
    y = y.reshape(bsz, s, SSM_INNER) * jax.nn.silu(z.astype(jnp.float32))
    y = rms_norm(y.reshape(bsz, s, G, SSM_INNER // G), norm_w.reshape(G, SSM_INNER // G))
    return y.reshape(bsz, s, SSM_INNER)


def hgrn2_mixer(q_raw, f_raw, i_raw, g_raw, lb, norm_w):
    bsz, s, _ = q_raw.shape
    C, dk, dv = HG_CHUNK, HG_KEY_DIM, HG_VAL_DIM
    nc = s // C
    q = jax.nn.silu(q_raw.astype(jnp.float32)) * dk ** -0.5
    fr = f_raw.astype(jnp.float32)
    log_f = jnp.log(lb + (1.0 - lb) * jax.nn.sigmoid(fr))
    k = (1.0 - lb) * jax.nn.sigmoid(-fr)
    v = i_raw.astype(jnp.float32)

    def to_chunks(t, d):
        return t.reshape(bsz, nc, C, HG_HEADS, d).transpose(1, 0, 3, 2, 4)

    tri = jnp.tril(jnp.ones((C, C), dtype=bool))[None, None, :, :, None]

    def step(state, inp):
        qc, kc, vc, gc = inp
        b = jnp.cumsum(gc, axis=2)
        o_inter = jnp.einsum('bhtd,bhde->bhte', qc * jnp.exp(b), state)
        seg = b[:, :, :, None, :] - b[:, :, None, :, :]
        dec = jnp.exp(jnp.where(tri, seg, NEG_INF))
        att = jnp.einsum('bhtd,bhsd,bhtsd->bhts', qc, kc, dec)
        o_intra = jnp.einsum('bhts,bhse->bhte', att, vc)
        b_last = b[:, :, -1:, :]
        state = state * jnp.exp(b_last[:, :, 0, :, None]) + jnp.einsum('bhsd,bhse->bhde', kc * jnp.exp(b_last - b), vc)
        return state, o_inter + o_intra

    s0 = jnp.zeros((bsz, HG_HEADS, dk, dv), jnp.float32)
    _, o = lax.scan(step, s0, (to_chunks(q, dk), to_chunks(k, dk), to_chunks(v, dv), to_chunks(log_f, dk)))
    o = o.transpose(1, 0, 3, 2, 4).reshape(bsz, s, HG_HEADS, dv)
    o = rms_norm(o, norm_w) * jax.nn.silu(g_raw.astype(jnp.float32)).reshape(bsz, s, HG_HEADS, dv)
    return o.reshape(bsz, s, HG_HEADS * dv)


def memory_cross_attention(h, mem, mem_norm, w_q, w_k, w_v, w_o, q_norm, k_norm):
    bsz, s, _ = h.shape
    m_len = mem.shape[1]
    q = rms_norm((h @ w_q).reshape(bsz, s, XA_HEADS, XA_HEAD_DIM), q_norm)
    m = rms_norm(mem, mem_norm)
    k = rms_norm((m @ w_k).reshape(bsz, m_len, XA_HEADS, XA_HEAD_DIM), k_norm)
    v = (m @ w_v).reshape(bsz, m_len, XA_HEADS, XA_HEAD_DIM)
    sc = jnp.einsum('bshd,bmhd->bhsm', q, k).astype(jnp.float32) * XA_HEAD_DIM ** -0.5
    p = jax.nn.softmax(sc, axis=-1)
    o = jnp.einsum('bhsm,bmhd->bshd', p, v)
    return o.reshape(bsz, s, XA_WIDTH) @ w_o


def swiglu_ffn(h, w_gate, w_up, w_down):
    return (jax.nn.silu(h @ w_gate) * (h @ w_up)) @ w_down


def setup_inputs(seed: int = 0) -> dict:
    key = jax.random.key(seed)
    keys = iter(jax.random.split(key, 64))

    def nrm(shape, scale):
        return jax.random.normal(next(keys), shape, jnp.float32) * scale

    def gain(shape):
        return 1.0 + nrm(shape, 0.05)

    L, D, hd = DEPTH, D_MODEL, NSA_HEAD_DIM
    dt0 = jnp.exp(jax.random.uniform(next(keys), (L, SSM_HEADS), jnp.float32, math.log(DT_MIN), math.log(DT_MAX)))
    a0 = jax.random.uniform(next(keys), (L, SSM_HEADS), jnp.float32, 1.0, 16.0)
    return {
        'x': nrm((BATCH, SEQ, D), 1.0),
        'mem': nrm((BATCH, MEM_LEN, D), 1.0),
        'norm_mix': gain((L, D)),
        'w_in': nrm((L, D, IN_DIM), D ** -0.5),
        'nsa_q_norm': gain((L, hd)),
        'nsa_k_norm': gain((L, hd)),
        'nsa_cmp_pos_k': nrm((L, NSA_CMP_BLOCK, hd), 0.1),
        'nsa_cmp_pos_v': nrm((L, NSA_CMP_BLOCK, hd), 0.1),
        'nsa_cmp_w1_k': nrm((L, NSA_CMP_BLOCK * hd, hd), (NSA_CMP_BLOCK * hd) ** -0.5),
        'nsa_cmp_w2_k': nrm((L, hd, hd), hd ** -0.5),
        'nsa_cmp_w1_v': nrm((L, NSA_CMP_BLOCK * hd, hd), (NSA_CMP_BLOCK * hd) ** -0.5),
        'nsa_cmp_w2_v': nrm((L, hd, hd), hd ** -0.5),
        'w_nsa_o': nrm((L, NSA_Q_WIDTH, D), NSA_Q_WIDTH ** -0.5),
        'ssm_conv_w': nrm((L, SSM_CONV, SSM_CONV_DIM), SSM_CONV ** -0.5),
        'ssm_conv_b': nrm((L, SSM_CONV_DIM), 0.02),
        'ssm_dt_bias': dt0 + jnp.log(-jnp.expm1(-dt0)),
        'ssm_a_log': jnp.log(a0),
        'ssm_d': 1.0 + nrm((L, SSM_HEADS), 0.1),
        'ssm_norm': gain((L, SSM_INNER)),
        'w_ssm_o': nrm((L, SSM_INNER, D), SSM_INNER ** -0.5),
        'hg_lb_logits': nrm((L, HG_WIDTH), 0.1),
        'hg_norm': gain((L, HG_VAL_DIM)),
        'w_hg_o': nrm((L, HG_HEADS * HG_VAL_DIM, D), (HG_HEADS * HG_VAL_DIM) ** -0.5),
        'w_out': nrm((L, D, D), D ** -0.5),
        'norm_xa': gain((L, D)),
        'norm_mem': gain((L, D)),
        'xa_w_q': nrm((L, D, XA_WIDTH), D ** -0.5),
        'xa_w_k': nrm((L, D, XA_WIDTH), D ** -0.5),
        'xa_w_v': nrm((L, D, XA_WIDTH), D ** -0.5),
        'xa_q_norm': gain((L, XA_HEAD_DIM)),
        'xa_k_norm': gain((L, XA_HEAD_DIM)),
        'xa_w_o': nrm((L, XA_WIDTH, D), XA_WIDTH ** -0.5),
        'norm_ffn': gain((L, D)),
        'ffn_w_gate': nrm((L, D, FFN_HIDDEN), D ** -0.5),
        'ffn_w_up': nrm((L, D, FFN_HIDDEN), D ** -0.5),
        'ffn_w_down': nrm((L, FFN_HIDDEN, D), FFN_HIDDEN ** -0.5),
    }


def reference(x, mem, norm_mix, w_in, nsa_q_norm, nsa_k_norm, nsa_cmp_pos_k, nsa_cmp_pos_v,
              nsa_cmp_w1_k, nsa_cmp_w2_k, nsa_cmp_w1_v, nsa_cmp_w2_v, w_nsa_o,
              ssm_conv_w, ssm_conv_b, ssm_dt_bias, ssm_a_log, ssm_d, ssm_norm, w_ssm_o,
              hg_lb_logits, hg_norm, w_hg_o, w_out,
              norm_xa, norm_mem, xa_w_q, xa_w_k, xa_w_v, xa_q_norm, xa_k_norm, xa_w_o,
              norm_ffn, ffn_w_gate, ffn_w_up, ffn_w_down):
    lb_sm = jax.nn.softmax(hg_lb_logits.astype(jnp.float32), axis=0)
    lb_all = jnp.cumsum(lb_sm, axis=0) - lb_sm[0:1]
    split_points = np.cumsum(SPLIT_SIZES)[:-1].tolist()
    for l in range(DEPTH):
        h = rms_norm(x, norm_mix[l])
        (a_q, a_kc, a_vc, a_ks, a_vs, a_kw, a_vw, a_gate,
         b_z, b_xbc, b_dt, c_q, c_f, c_i, c_g, g_a, g_b, g_c) = jnp.split(h @ w_in[l], split_points, axis=-1)
        y_a = nsa_mixer(a_q, a_kc, a_vc, a_ks, a_vs, a_kw, a_vw, a_gate, nsa_q_norm[l], nsa_k_norm[l],
                        nsa_cmp_pos_k[l], nsa_cmp_pos_v[l], nsa_cmp_w1_k[l], nsa_cmp_w2_k[l],
                        nsa_cmp_w1_v[l], nsa_cmp_w2_v[l]) @ w_nsa_o[l]
        y_b = mamba2_mixer(b_z, b_xbc, b_dt, ssm_conv_w[l], ssm_conv_b[l], ssm_dt_bias[l],
                           ssm_a_log[l], ssm_d[l], ssm_norm[l]) @ w_ssm_o[l]
        y_c = hgrn2_mixer(c_q, c_f, c_i, c_g, lb_all[l], hg_norm[l]) @ w_hg_o[l]
        merged = jax.nn.sigmoid(g_a) * y_a + jax.nn.sigmoid(g_b) * y_b + jax.nn.sigmoid(g_c) * y_c
        x = x + (merged @ w_out[l]).astype(x.dtype)
        x = x + memory_cross_attention(rms_norm(x, norm_xa[l]), mem, norm_mem[l], xa_w_q[l], xa_w_k[l],
                                       xa_w_v[l], xa_w_o[l], xa_q_norm[l], xa_k_norm[l]).astype(x.dtype)
        x = x + swiglu_ffn(rms_norm(x, norm_ffn[l]), ffn_w_gate[l], ffn_w_up[l], ffn_w_down[l]).astype(x.dtype)
    return x
```

```cpp
#include <hip/hip_runtime.h>
#include <hip/hip_cooperative_groups.h>
#include <cstdio>
#include <cstdint>
namespace cg = cooperative_groups;
namespace pg8 {
#define PG8_LAS __attribute__((address_space(3)))
typedef unsigned short bf16_t;
typedef short bf16x8 __attribute__((ext_vector_type(8)));
typedef float f32x4 __attribute__((ext_vector_type(4)));
typedef unsigned u32x4 __attribute__((ext_vector_type(4)));
constexpr int BM = 256, BK = 64, HALF = 128, HTB = HALF * BK * 2  , STAGE_BYTES = 8 * HTB, NXCD = 8, WGM = 8;

__host__ __device__ __forceinline__ int lds_byte(int r, int c) { const int st = (r >> 4) * 2 + (c >> 5), rr = r & 15, cc = c & 31, ob = rr * 64 + cc * 2; return st * 1024 + (ob ^ (((ob >> 9) & 1) << 5)); }
__host__ __device__ __forceinline__ void stage_rc(int b, int& R, int& C) { const int st = b / 1024, sb = b % 1024, swz = sb ^ (((sb >> 9) & 1) << 5); R = (st >> 1) * 16 + swz / 64; C = (st & 1) * 32 + (swz % 64) / 2; }
__host__ __device__ __forceinline__ int perm32(int rho) { const int n = rho >> 4, i = rho & 15; return 8 * (i >> 2) + 4 * n + (i & 3); }

struct Unit { int pm, pn; };
struct Gemm { const bf16_t* A; const bf16_t* Bt; int M, N, K, lda, ldb; };

struct StaticOrder {
    int nM, nN, nwg, G, c;
    __host__ __device__ void init(int M, int N, int G_, int c_) { nM = M / BM; nN = N / BM; nwg = nM * nN; G = G_; c = c_; }
    __host__ __device__ bool next(int i, Unit& u) const {
        const long L = (long)i * G + c; if (L >= nwg) return false;
        int wgid = (int)L; { const int q = nwg / NXCD, r = nwg % NXCD, xcd = wgid % NXCD, off = wgid / NXCD; wgid = (xcd < r ? xcd * (q + 1) : r * (q + 1) + (xcd - r) * q) + off; }
        const int nig = WGM * nN, gid = wgid / nig, fm = gid * WGM, gsz = (nM - fm) < WGM ? (nM - fm) : WGM;
        u.pm = fm + ((wgid % nig) % gsz); u.pn = (wgid % nig) / gsz; return true;
    }
    __device__ __forceinline__ void a_ready(const Unit&) const {}
    __device__ __forceinline__ void done(const Unit&) const {}
};

typedef __bf16 bf16n2_t __attribute__((ext_vector_type(2)));
__device__ __forceinline__ unsigned cvt_pk_bf16(float lo, float hi) { bf16n2_t v; v.x = (__bf16)lo; v.y = (__bf16)hi; return __builtin_bit_cast(unsigned, v); }

typedef unsigned u32x2 __attribute__((ext_vector_type(2)));
__device__ __forceinline__ float sigm(float x) { return __builtin_amdgcn_rcpf(1.0f + __expf(-x)); }
template <int ACT> struct EpiStore {
    static constexpr bool PERM = true, AFTER_DRAIN = false;
    bf16_t* O; int ldc; int ncols;
    __device__ __forceinline__ void operator()(const f32x4 (&acc)[2][2][4][2], const Unit& u, int wr, int wc, int fr, int fq) const {
        const int row0 = u.pm * BM + wr * 64 + fr, col0 = u.pn * BM + wc * 32 + 8 * fq;
#pragma unroll
        for (int ai = 0; ai < 2; ++ai)
#pragma unroll
            for (int m = 0; m < 4; ++m) { bf16_t* rowp = O + (size_t)(row0 + ai * HALF + m * 16) * ldc;
#pragma unroll
                for (int bj = 0; bj < 2; ++bj) { const int c = col0 + bj * HALF; if (c < ncols) {
                    f32x4 v0 = acc[ai][bj][m][0], v1 = acc[ai][bj][m][1];
                    if (ACT == 1) { v0 = (f32x4){sigm(v0[0]), sigm(v0[1]), sigm(v0[2]), sigm(v0[3])}; v1 = (f32x4){sigm(v1[0]), sigm(v1[1]), sigm(v1[2]), sigm(v1[3])}; }
                    u32x4 w; w.x = cvt_pk_bf16(v0[0], v0[1]); w.y = cvt_pk_bf16(v0[2], v0[3]); w.z = cvt_pk_bf16(v1[0], v1[1]); w.w = cvt_pk_bf16(v1[2], v1[3]);
                    *(u32x4*)(rowp + c) = w; } } }
    }
};
struct EpiMerge {
    static constexpr bool PERM = true, AFTER_DRAIN = false;
    const bf16_t* SG; int ldsg; bf16_t* Mg; int ldm; int accum;
    __device__ __forceinline__ void operator()(const f32x4 (&acc)[2][2][4][2], const Unit& u, int wr, int wc, int fr, int fq) const {
        const int row0 = u.pm * BM + wr * 64 + fr, col0 = u.pn * BM + wc * 32 + 8 * fq;
#pragma unroll
        for (int ai = 0; ai < 2; ++ai)
#pragma unroll
            for (int m = 0; m < 4; ++m) { const size_t r = (size_t)(row0 + ai * HALF + m * 16);
#pragma unroll
                for (int bj = 0; bj < 2; ++bj) { const int c = col0 + bj * HALF;
                    const u32x4 s = *(const u32x4*)(SG + r * ldsg + c);
                    u32x4 o = (u32x4){0u, 0u, 0u, 0u}; if (accum) o = *(const u32x4*)(Mg + r * ldm + c);
                    const f32x4 v0 = acc[ai][bj][m][0], v1 = acc[ai][bj][m][1];
                    float f[8] = {v0[0], v0[1], v0[2], v0[3], v1[0], v1[1], v1[2], v1[3]};
                    unsigned sw[4] = {s.x, s.y, s.z, s.w}, ow[4] = {o.x, o.y, o.z, o.w}, rw[4];
#pragma unroll
                    for (int q = 0; q < 4; ++q) {
                        const float a = __uint_as_float(ow[q] << 16) + __uint_as_float(sw[q] << 16) * f[2 * q];
                        const float b = __uint_as_float(ow[q] & 0xffff0000u) + __uint_as_float(sw[q] & 0xffff0000u) * f[2 * q + 1];
                        rw[q] = cvt_pk_bf16(a, b); }
                    *(u32x4*)(Mg + r * ldm + c) = (u32x4){rw[0], rw[1], rw[2], rw[3]}; } }
    }
};
struct EpiResid {
    static constexpr bool PERM = false, AFTER_DRAIN = false;
    const float* base; float* out; int ldc;
    __device__ __forceinline__ void operator()(const f32x4 (&acc)[2][2][4][2], const Unit& u, int wr, int wc, int fr, int fq) const {
        const int row0 = u.pm * BM + wr * 64 + fr, col0 = u.pn * BM + wc * 32 + 4 * fq;
#pragma unroll
        for (int ai = 0; ai < 2; ++ai)
#pragma unroll
            for (int m = 0; m < 4; ++m) { const size_t off = (size_t)(row0 + ai * HALF + m * 16) * ldc + col0;
#pragma unroll
                for (int bj = 0; bj < 2; ++bj)
#pragma unroll
                    for (int n = 0; n < 2; ++n) { const f32x4 bs = *(const f32x4*)(base + off + bj * HALF + n * 16); *(f32x4*)(out + off + bj * HALF + n * 16) = bs + acc[ai][bj][m][n]; } }
    }
};
struct EpiSwiglu {
    static constexpr bool PERM = true, AFTER_DRAIN = false;
    bf16_t* O; int ldc;
    __device__ __forceinline__ void operator()(const f32x4 (&acc)[2][2][4][2], const Unit& u, int wr, int wc, int fr, int fq) const {
        const int row0 = u.pm * BM + wr * 64 + fr, col0 = u.pn * HALF + wc * 32 + 8 * fq;
#pragma unroll
        for (int ai = 0; ai < 2; ++ai)
#pragma unroll
            for (int m = 0; m < 4; ++m) { bf16_t* rowp = O + (size_t)(row0 + ai * HALF + m * 16) * ldc + col0;
                float h[8];
#pragma unroll
                for (int n = 0; n < 2; ++n)
#pragma unroll
                    for (int q = 0; q < 4; ++q) { const float g = acc[ai][0][m][n][q], up = acc[ai][1][m][n][q]; h[n * 4 + q] = g * sigm(g) * up; }
                u32x4 w; w.x = cvt_pk_bf16(h[0], h[1]); w.y = cvt_pk_bf16(h[2], h[3]); w.z = cvt_pk_bf16(h[4], h[5]); w.w = cvt_pk_bf16(h[6], h[7]);
                *(u32x4*)rowp = w; }
    }
};

template <class Epi, class Sched, bool ALIGN_EPI = false, bool SP2 = false>
__device__ __forceinline__ void gemm_phase(PG8_LAS unsigned char* lds, const Gemm g, const Sched& S, const Epi& E) {
    int tid_ = threadIdx.x; asm volatile("" : "+v"(tid_));
    const int tid = tid_, wid = __builtin_amdgcn_readfirstlane(tid >> 6), lane = tid & 63, wr = wid >> 2, wc = wid & 3, fr = lane & 15, fq = lane >> 4;
    const int K = g.K, nt = K / BK;
    unsigned voffA[2], voffB[2];
#pragma unroll
    for (int i = 0; i < 2; ++i) { int R, C; stage_rc(tid * 16 + i * 8192, R, C); const int Rb = Epi::PERM ? ((R & ~31) + perm32(R & 31)) : R;
        voffA[i] = (unsigned)(R * g.lda + C) * 2u; voffB[i] = (unsigned)(Rb * g.ldb + C) * 2u; }
    const size_t kstep = (size_t)(BK * 2);
    const size_t hstepA = (size_t)HALF * g.lda * 2, hstepB = (size_t)HALF * g.ldb * 2;
    const size_t tstepA = 2 * hstepA, tstepB = 2 * hstepB;
    const unsigned ldsw = (unsigned)wid * 1024u;
    const int aoff = lds_byte(wr * 64 + fr, fq * 8), boff = lds_byte(wc * 32 + fr, fq * 8);
#define PG8_SA(b, h) (((b) * 2 + (h)) * HTB)
#define PG8_SB(b, h) ((4 + (b) * 2 + (h)) * HTB)
#define PG8_STAGE(bufoff, gbase, voff) do { _Pragma("unroll") for (int _i = 0; _i < 2; ++_i) \
        __builtin_amdgcn_global_load_lds((const unsigned*)((const char*)(gbase) + (voff)[_i]), (PG8_LAS unsigned*)(lds + (bufoff) + ldsw + _i * 8192), 16, 0, 0); } while (0)
#define PG8_LDA(dst, b, h) do { _Pragma("unroll") for (int m = 0; m < 4; ++m) _Pragma("unroll") for (int k = 0; k < 2; ++k) dst[m][k] = *(const PG8_LAS bf16x8*)(lds + PG8_SA(b, h) + aoff + m * 2048 + k * 1024); } while (0)
#define PG8_LDB(dst, b, h) do { _Pragma("unroll") for (int n = 0; n < 2; ++n) _Pragma("unroll") for (int k = 0; k < 2; ++k) dst[n][k] = *(const PG8_LAS bf16x8*)(lds + PG8_SB(b, h) + boff + n * 2048 + k * 1024); } while (0)
#define PG8_MMA(ai, bj, At, Bt) do { __builtin_amdgcn_s_setprio(1); _Pragma("unroll") for (int m = 0; m < 4; ++m) _Pragma("unroll") for (int n = 0; n < 2; ++n) _Pragma("unroll") for (int k = 0; k < 2; ++k) \
        acc[ai][bj][m][n] = __builtin_amdgcn_mfma_f32_16x16x32_bf16(Bt[n][k], At[m][k], acc[ai][bj][m][n], 0, 0, 0); __builtin_amdgcn_s_setprio(0); } while (0)
#define PG8_WAIT_V(n) asm volatile("s_waitcnt vmcnt(" #n ")" ::: "memory")
#define PG8_WAIT_L(n) asm volatile("s_waitcnt lgkmcnt(" #n ")" ::: "memory")
#define PG8_BAR __builtin_amdgcn_s_barrier()
#define PG8_SCHED __builtin_amdgcn_sched_barrier(0)
    Unit cur, nxt; int ui = 0;
    if (!S.next(0, cur)) return;
    f32x4 acc[2][2][4][2];
#pragma unroll
    for (int a = 0; a < 2; ++a)
#pragma unroll
        for (int b = 0; b < 2; ++b)
#pragma unroll
            for (int m = 0; m < 4; ++m)
#pragma unroll
                for (int n = 0; n < 2; ++n) acc[a][b][m][n] = (f32x4){0.f, 0.f, 0.f, 0.f};
    bf16x8 At[4][2], B0[2][2], B1[2][2];
    const char* cA = (const char*)g.A + (size_t)cur.pm * tstepA; const char* cB = (const char*)g.Bt + (size_t)cur.pn * tstepB;
    S.a_ready(cur);
    if constexpr (SP2) {
        PG8_STAGE(PG8_SB(0, 0), cB, voffB); PG8_STAGE(PG8_SB(0, 1), cB + hstepB, voffB); PG8_STAGE(PG8_SA(0, 0), cA, voffA); PG8_STAGE(PG8_SA(0, 1), cA + hstepA, voffA);
        if (wr == 1) PG8_BAR;
        PG8_WAIT_V(2); PG8_BAR;
        PG8_STAGE(PG8_SB(1, 0), cB + kstep, voffB); PG8_STAGE(PG8_SA(1, 0), cA + kstep, voffA); PG8_STAGE(PG8_SB(1, 1), cB + hstepB + kstep, voffB);
        PG8_WAIT_V(6); PG8_BAR;
    } else {
        PG8_STAGE(PG8_SB(0, 0), cB, voffB); PG8_STAGE(PG8_SA(0, 0), cA, voffA); PG8_STAGE(PG8_SB(0, 1), cB + hstepB, voffB); PG8_STAGE(PG8_SA(0, 1), cA + hstepA, voffA);
        if (wr == 1) PG8_BAR;
        PG8_WAIT_V(4); PG8_BAR;
        PG8_STAGE(PG8_SB(1, 0), cB + kstep, voffB); PG8_STAGE(PG8_SA(1, 0), cA + kstep, voffA); PG8_STAGE(PG8_SB(1, 1), cB + hstepB + kstep, voffB);
        PG8_WAIT_V(6); PG8_BAR;
    }
    for (;;) {
        const bool has_next = S.next(ui + 1, nxt);
        const char* nA = has_next ? (const char*)g.A + (size_t)nxt.pm * tstepA : cA; const char* nB = has_next ? (const char*)g.Bt + (size_t)nxt.pn * tstepB : cB;
        for (int t = 0; t < nt; t += 2) {
            const bool last = (t == nt - 2);
            const char* a1 = cA + (size_t)(t + 1) * kstep;
            const char* a2 = last ? nA : cA + (size_t)(t + 2) * kstep; const char* b2 = last ? nB : cB + (size_t)(t + 2) * kstep;
            const char* a3 = a2 + kstep; const char* b3 = b2 + kstep;
            if (last && has_next) S.a_ready(nxt);
            if constexpr (SP2) {
            PG8_LDB(B0, 0, 0); PG8_LDB(B1, 0, 1); PG8_SCHED; PG8_LDA(At, 0, 0); PG8_STAGE(PG8_SA(1, 1), a1 + hstepA, voffA);
            PG8_WAIT_V(8); PG8_WAIT_L(0); PG8_BAR; PG8_MMA(0, 0, At, B0); PG8_MMA(0, 1, At, B1); PG8_BAR; PG8_SCHED;
            PG8_LDA(At, 0, 1); PG8_STAGE(PG8_SB(0, 0), b2, voffB); PG8_STAGE(PG8_SB(0, 1), b2 + hstepB, voffB); PG8_STAGE(PG8_SA(0, 0), a2, voffA);
            PG8_WAIT_V(8); PG8_WAIT_L(0); PG8_BAR; PG8_MMA(1, 0, At, B0); PG8_MMA(1, 1, At, B1); PG8_BAR; PG8_SCHED;
            PG8_LDB(B0, 1, 0); PG8_LDB(B1, 1, 1); PG8_SCHED; PG8_LDA(At, 1, 0); PG8_STAGE(PG8_SA(0, 1), a2 + hstepA, voffA);
            PG8_WAIT_V(8); PG8_WAIT_L(0); PG8_BAR; PG8_MMA(0, 0, At, B0); PG8_MMA(0, 1, At, B1); PG8_BAR; PG8_SCHED;
            PG8_LDA(At, 1, 1); PG8_STAGE(PG8_SB(1, 0), b3, voffB); PG8_STAGE(PG8_SB(1, 1), b3 + hstepB, voffB); PG8_STAGE(PG8_SA(1, 0), a3, voffA);
            PG8_WAIT_V(8); PG8_WAIT_L(0); PG8_BAR; PG8_MMA(1, 0, At, B0); PG8_MMA(1, 1, At, B1); PG8_BAR; PG8_SCHED;
            } else {
            PG8_LDB(B0, 0, 0); PG8_SCHED; PG8_LDA(At, 0, 0); PG8_STAGE(PG8_SA(1, 1), a1 + hstepA, voffA);
            PG8_WAIT_L(8); PG8_BAR; PG8_WAIT_L(0); PG8_MMA(0, 0, At, B0); PG8_BAR; PG8_SCHED;
            PG8_LDB(B1, 0, 1); PG8_STAGE(PG8_SB(0, 0), b2, voffB);
            PG8_BAR; PG8_WAIT_L(0); PG8_MMA(0, 1, At, B1); PG8_BAR;
            PG8_LDA(At, 0, 1); PG8_STAGE(PG8_SA(0, 0), a2, voffA);
            PG8_BAR; PG8_WAIT_L(0); PG8_MMA(1, 0, At, B0); PG8_BAR; PG8_SCHED;
            PG8_STAGE(PG8_SB(0, 1), b2 + hstepB, voffB);
            PG8_WAIT_V(6); PG8_BAR; PG8_MMA(1, 1, At, B1); PG8_BAR;
            PG8_LDB(B0, 1, 0); PG8_SCHED; PG8_LDA(At, 1, 0); PG8_STAGE(PG8_SA(0, 1), a2 + hstepA, voffA);
            PG8_WAIT_L(8); PG8_BAR; PG8_WAIT_L(0); PG8_MMA(0, 0, At, B0); PG8_BAR; PG8_SCHED;
            PG8_LDB(B1, 1, 1); PG8_STAGE(PG8_SB(1, 0), b3, voffB);
            PG8_BAR; PG8_WAIT_L(0); PG8_MMA(0, 1, At, B1); PG8_BAR;
            PG8_LDA(At, 1, 1); PG8_STAGE(PG8_SA(1, 0), a3, voffA);
            PG8_BAR; PG8_WAIT_L(0); PG8_MMA(1, 0, At, B0); PG8_BAR; PG8_SCHED;
            PG8_STAGE(PG8_SB(1, 1), b3 + hstepB, voffB);
            PG8_WAIT_V(6); PG8_BAR; PG8_MMA(1, 1, At, B1); PG8_BAR;
            }
        }
        if constexpr (ALIGN_EPI) { if (wr == 0) PG8_BAR; }
        if constexpr (!Epi::AFTER_DRAIN) { E(acc, cur, wr, wc, fr, fq); S.done(cur); }
        if (!has_next) break;
#pragma unroll
        for (int a = 0; a < 2; ++a)
#pragma unroll
            for (int b = 0; b < 2; ++b)
#pragma unroll
                for (int m = 0; m < 4; ++m)
#pragma unroll
                    for (int n = 0; n < 2; ++n) acc[a][b][m][n] = (f32x4){0.f, 0.f, 0.f, 0.f};
        cur = nxt; cA = nA; cB = nB; ++ui;
        if constexpr (ALIGN_EPI) { if (wr == 1) PG8_BAR; }
    }
    PG8_WAIT_V(0);
    if constexpr (!ALIGN_EPI) { if (wr == 0) PG8_BAR; }
    PG8_BAR;
    if constexpr (Epi::AFTER_DRAIN) { E.fused(acc, cur, wr, wc, fr, fq, lds, wid, lane); S.done(cur); }
#undef PG8_SA
#undef PG8_SB
#undef PG8_STAGE
#undef PG8_LDA
#undef PG8_LDB
#undef PG8_MMA
#undef PG8_WAIT_V
#undef PG8_WAIT_L
#undef PG8_BAR
#undef PG8_SCHED
}
}

#define DI __device__ __forceinline__
#define LAS __attribute__((address_space(3)))
typedef unsigned short bf16_t;
typedef short bf16x8 __attribute__((ext_vector_type(8)));
typedef float f32x4 __attribute__((ext_vector_type(4)));
typedef unsigned u32x4 __attribute__((ext_vector_type(4)));
typedef unsigned u32x2 __attribute__((ext_vector_type(2)));
#define MFMA16(a, b, c) __builtin_amdgcn_mfma_f32_16x16x32_bf16((a), (b), (c), 0, 0, 0)

constexpr int Dm = 1024, NB = 2, S = 16384, M = NB * S, DEPTH = 2;
constexpr int LDP = 4672, NP1 = 4640, NIN1 = 4864, NGATE = 3072, FFH = 2816;
constexpr float EPS = 1e-6f;
constexpr int C_Q = 0, C_KC = 512, C_VC = 640, C_KS = 768, C_VS = 896, C_KW = 1024, C_VW = 1152, C_NG = 1280, C_Z = 1304, C_XBC = 1816, C_DT = 2584,
              C_HQ = 2592, C_HF = 3104, C_HI = 3616, C_HG = 4128, C_SG = 1856;
constexpr size_t WT_IN = 0, WT_G = WT_IN + (size_t)NIN1 * 1024, WT_NSAO = WT_G + (size_t)NGATE * 1024, WT_SSMO = WT_NSAO + 1024 * 512, WT_HGO = WT_SSMO + 1024 * 512,
                 WT_OUT = WT_HGO + 1024 * 512, WT_XQ = WT_OUT + 1024 * 1024, WT_XKV = WT_XQ + 512 * 1024, WT_XO = WT_XKV + 1024 * 1024, WT_GU = WT_XO + 1024 * 512,
                 WT_DN = WT_GU + (size_t)2 * FFH * 1024, WT_C1K = WT_DN + (size_t)1024 * FFH, WT_C2K = WT_C1K + 64 * 2048, WT_C1V = WT_C2K + 64 * 64, WT_C2V = WT_C1V + 64 * 2048,
                 WT_END = WT_C2V + 64 * 64;
constexpr size_t MiB = 1u << 20;
constexpr size_t OFF_W = 0, OFF_H = 42 * MiB, OFF_P1 = 106 * MiB, OFF_SST = 398 * MiB, OFF_HST = 414 * MiB, OFF_VT = 478 * MiB, OFF_SM = 494 * MiB;
static_assert(WT_END * 2 <= OFF_H, "weights fit");
static_assert(OFF_P1 + (size_t)M * LDP * 2 <= OFF_SST, "P1 fits");
constexpr size_t SM_KC = OFF_SM, SM_VCT = SM_KC + 512 * 1024, SM_MN = SM_VCT + 512 * 1024, SM_KVX = SM_MN + MiB, SM_XVT = SM_KVX + MiB, SM_CDEC = SM_XVT + 512 * 1024,
                 SM_HDEC = SM_CDEC + 64 * 1024, SM_CB = SM_HDEC + MiB, SM_BAR = SM_CB + 4096, WS_END = SM_BAR + 16384;

DI float bf2f(bf16_t v) { return __uint_as_float((unsigned)v << 16); }
typedef __bf16 bf16n2 __attribute__((ext_vector_type(2)));
DI unsigned pk2(float lo, float hi) { bf16n2 v; v.x = (__bf16)lo; v.y = (__bf16)hi; return __builtin_bit_cast(unsigned, v); }
DI bf16_t f2bf(float f) { return (bf16_t)(pk2(f, 0.f) & 0xffffu); }
DI float lo16(unsigned w) { return __uint_as_float(w << 16); }
DI float hi16(unsigned w) { return __uint_as_float(w & 0xffff0000u); }
template <int CTRL> DI float dpp_f(float v) { return __builtin_bit_cast(float, __builtin_amdgcn_update_dpp(0, __builtin_bit_cast(int, v), CTRL, 0xF, 0xF, true)); }
DI float sum4(float v) { v += dpp_f<0xB1>(v); v += dpp_f<0x4E>(v); return v; }
DI float sum16(float v) { v += dpp_f<0x128>(v); v += dpp_f<0x124>(v); return sum4(v); }
DI float wave_sum(float v) { v = sum16(v); v += __shfl_xor(v, 16); v += __shfl_xor(v, 32); return v; }
DI float wave_max(float v) {
#pragma unroll
    for (int o = 1; o < 64; o <<= 1) v = fmaxf(v, __shfl_xor(v, o));
    return v;
}
DI float sigmf(float x) { return __builtin_amdgcn_rcpf(1.0f + __expf(-x)); }
DI float siluf(float x) { return x * __builtin_amdgcn_rcpf(1.0f + __expf(-x)); }
DI bf16x8 ldg8(const bf16_t* p) { return *(const bf16x8*)p; }
DI bf16x8 lds8(const LAS bf16_t* p) { return *(const LAS bf16x8*)p; }
DI bf16x8 pack8(const float* f) { u32x4 w; w.x = pk2(f[0], f[1]); w.y = pk2(f[2], f[3]); w.z = pk2(f[4], f[5]); w.w = pk2(f[6], f[7]); return __builtin_bit_cast(bf16x8, w); }
DI void unpack8(bf16x8 v, float* f) { u32x4 w = __builtin_bit_cast(u32x4, v); f[0] = lo16(w.x); f[1] = hi16(w.x); f[2] = lo16(w.y); f[3] = hi16(w.y); f[4] = lo16(w.z); f[5] = hi16(w.z); f[6] = lo16(w.w); f[7] = hi16(w.w); }


DI void sincos_rad(float ang, float* sn, float* cs) {
    const float hi = ang * 0.15915494309189535f; const float lo = fmaf(ang, 0.15915494309189535f, -hi) + ang * 6.4206383266e-09f;
    const float fr = (hi - rintf(hi)) + lo;
    *sn = __builtin_amdgcn_sinf(fr); *cs = __builtin_amdgcn_cosf(fr);
}
DI float rope_inv_freq(int i) { return __builtin_amdgcn_exp2f(-(float)i * (13.287712379549449f / 32.0f)); }
struct Params { const float* in[36]; float* out; unsigned char* ws; };
typedef const __attribute__((address_space(4))) Params* KP;

DI void transpose_item(const float* W, int ld, int c0, int K, int N, bf16_t* WT, int mode, LAS float* scr, int item, int lane) {
    const int nblk = N / 32, kb = item / nblk, nb = item % nblk, k0 = 64 * kb, n0 = 32 * nb;
#pragma unroll 8
    for (int i = 0; i < 32; ++i) { const int kk = 2 * i + (lane >> 5); scr[kk * 33 + (lane & 31)] = W[(size_t)(k0 + kk) * ld + c0 + n0 + (lane & 31)]; }
    const int c = lane & 7;
#pragma unroll
    for (int j = 0; j < 4; ++j) { const int nl = (lane >> 3) + 8 * j; const LAS float* s = scr + (8 * c) * 33 + nl;
        u32x4 o; o.x = pk2(s[0 * 33], s[1 * 33]); o.y = pk2(s[2 * 33], s[3 * 33]); o.z = pk2(s[4 * 33], s[5 * 33]); o.w = pk2(s[6 * 33], s[7 * 33]);
        const int n = n0 + nl; int row = n; if (mode == 1) row = (n >> 7) * 256 + (n & 127); else if (mode == 2) row = (n >> 7) * 256 + 128 + (n & 127);
        *(u32x4*)(WT + (size_t)row * K + k0 + 8 * c) = o; }
}
DI void transpose_job(const float* W, int ld, int c0, int K, int N, bf16_t* WT, int mode, LAS float* scr, int gw, int NGW, int lane) {
    const int nitems = (K / 64) * (N / 32);
    for (int it = gw; it < nitems; it += NGW) transpose_item(W, ld, c0, K, N, WT, mode, scr, it, lane);
}
DI void rms_row(const float* xrow, const float* w, bf16_t* orow, int lane) {
    const f32x4* xr = (const f32x4*)xrow + lane; const f32x4* wr = (const f32x4*)w + lane;
    f32x4 v[4]; float s = 0.f;
#pragma unroll
    for (int j = 0; j < 4; ++j) { v[j] = xr[64 * j]; s += (v[j].x * v[j].x + v[j].y * v[j].y) + (v[j].z * v[j].z + v[j].w * v[j].w); }
    const float r = rsqrtf(wave_sum(s) * (1.f / 1024.f) + EPS);
    u32x2* o8 = (u32x2*)orow + lane;
#pragma unroll
    for (int j = 0; j < 4; ++j) { const f32x4 g = wr[64 * j]; u32x2 o; o.x = pk2(v[j].x * r * g.x, v[j].y * r * g.y); o.y = pk2(v[j].z * r * g.z, v[j].w * r * g.w); o8[64 * j] = o; }
}
DI void rms_phase(const float* x, const float* w, bf16_t* H, int nrows, int gw, int NGW, int lane) {
    const f32x4* wr = (const f32x4*)w + lane; f32x4 g[4];
#pragma unroll
    for (int j = 0; j < 4; ++j) g[j] = wr[64 * j];
    for (int m = gw; m < nrows; m += 2 * NGW) {
        const int m2 = m + NGW; const bool has2 = m2 < nrows; const int mm2 = has2 ? m2 : m;
        const f32x4* x0 = (const f32x4*)(x + (size_t)m * 1024) + lane; const f32x4* x1 = (const f32x4*)(x + (size_t)mm2 * 1024) + lane;
        f32x4 v0[4], v1[4]; float s0 = 0.f, s1 = 0.f;
#pragma unroll
        for (int j = 0; j < 4; ++j) { v0[j] = x0[64 * j]; v1[j] = x1[64 * j]; }
#pragma unroll
        for (int j = 0; j < 4; ++j) { s0 += (v0[j].x * v0[j].x + v0[j].y * v0[j].y) + (v0[j].z * v0[j].z + v0[j].w * v0[j].w); s1 += (v1[j].x * v1[j].x + v1[j].y * v1[j].y) + (v1[j].z * v1[j].z + v1[j].w * v1[j].w); }
        const float r0 = rsqrtf(wave_sum(s0) * (1.f / 1024.f) + EPS), r1 = rsqrtf(wave_sum(s1) * (1.f / 1024.f) + EPS);
        u32x2* o0 = (u32x2*)(H + (size_t)m * 1024) + lane; u32x2* o1 = (u32x2*)(H + (size_t)mm2 * 1024) + lane;
#pragma unroll
        for (int j = 0; j < 4; ++j) { u32x2 o; o.x = pk2(v0[j].x * r0 * g[j].x, v0[j].y * r0 * g[j].y); o.y = pk2(v0[j].z * r0 * g[j].z, v0[j].w * r0 * g[j].w); o0[64 * j] = o; }
        if (has2) {
#pragma unroll
            for (int j = 0; j < 4; ++j) { u32x2 o; o.x = pk2(v1[j].x * r1 * g[j].x, v1[j].y * r1 * g[j].y); o.y = pk2(v1[j].z * r1 * g[j].z, v1[j].w * r1 * g[j].w); o1[64 * j] = o; } }
    }
}


constexpr int NTJ = 17;
__device__ const int TJ_IN[NTJ]   = {3, 3, 12, 19, 22, 23, 26, 27, 28, 31, 33, 34, 35, 8, 9, 10, 11};
__device__ const int TJ_LD[NTJ]   = {7712, 7712, 1024, 1024, 1024, 1024, 512, 512, 512, 1024, FFH, FFH, 1024, 64, 64, 64, 64};
__device__ const int TJ_C0[NTJ]   = {0, 4640, 0, 0, 0, 0, 0, 0, 0, 0, 0, 0, 0, 0, 0, 0, 0};
__device__ const int TJ_K[NTJ]    = {1024, 1024, 512, 512, 512, 1024, 1024, 1024, 1024, 512, 1024, 1024, FFH, 2048, 64, 2048, 64};
__device__ const int TJ_N[NTJ]    = {4640, 3072, 1024, 1024, 1024, 1024, 512, 512, 512, 1024, FFH, FFH, 1024, 64, 64, 64, 64};
__device__ const int TJ_MODE[NTJ] = {0, 0, 0, 0, 0, 0, 0, 0, 0, 0, 1, 2, 0, 0, 0, 0, 0};
__device__ const unsigned TJ_WT[NTJ] = {(unsigned)WT_IN, (unsigned)WT_G, (unsigned)WT_NSAO, (unsigned)WT_SSMO, (unsigned)WT_HGO, (unsigned)WT_OUT, (unsigned)WT_XQ, (unsigned)WT_XKV, (unsigned)(WT_XKV + 512 * 1024),
                                        (unsigned)WT_XO, (unsigned)WT_GU, (unsigned)WT_GU, (unsigned)WT_DN, (unsigned)WT_C1K, (unsigned)WT_C2K, (unsigned)WT_C1V, (unsigned)WT_C2V};
DI void prep_phase(KP p, int l, LAS unsigned char* lds, int wave, int lane, int gw, int NGW) {
    bf16_t* W = (bf16_t*)(p->ws + OFF_W);
    LAS float* scr = (LAS float*)(lds + wave * 16384);
    { int tot = 0;
#pragma unroll
      for (int j = 0; j < NTJ; ++j) tot += (TJ_K[j] / 64) * (TJ_N[j] / 32);
      for (int it = gw; it < tot; it += NGW) {
        int r = it, j = 0;
#pragma unroll
        for (int q = 0; q < NTJ - 1; ++q) { const int n = (TJ_K[q] / 64) * (TJ_N[q] / 32); if (j == q && r >= n) { r -= n; j = q + 1; } }
        const float* src = p->in[TJ_IN[j]] + (size_t)l * TJ_K[j] * TJ_LD[j];
        transpose_item(src, TJ_LD[j], TJ_C0[j], TJ_K[j], TJ_N[j], W + TJ_WT[j], TJ_MODE[j], scr, r, lane);
      } }
    { u32x4* z = (u32x4*)(W + WT_IN + (size_t)4640 * 1024); const int n16 = 224 * 1024 * 2 / 16;
      for (int i = gw * 64 + lane; i < n16; i += NGW * 64) z[i] = (u32x4){0u, 0u, 0u, 0u}; }
    if (gw < 8) { float* cbv = (float*)(p->ws + SM_CB);
      for (int o = gw; o < 128; o += 8) { const int kv = o >> 6, c = o & 63; const float* pos = p->in[6 + kv] + (size_t)l * 2048; const float* w1 = p->in[kv ? 10 : 8] + (size_t)l * 2048 * 64;
        float s = 0.f; for (int i = lane; i < 2048; i += 64) s += pos[i] * w1[(size_t)i * 64 + c];
        s = wave_sum(s); if (lane == 0) cbv[o] = s; } }
    rms_phase(p->in[1], p->in[25] + (size_t)l * 1024, (bf16_t*)(p->ws + SM_MN), 512, gw, NGW, lane);
    rms_phase(l == 0 ? p->in[0] : p->out, p->in[2] + (size_t)l * 1024, (bf16_t*)(p->ws + OFF_H), M, gw, NGW, lane);
}
#define XB_TMO      128
#define XB_XCNT(j)  (256  + 64 * (j))
#define XB_XSUB(j)  (1280 + 64 * (j))
#define XB_XGEN(j)  (2304 + 64 * (j))
#define XB_TOP      3328
#define XB_TOPGEN   3392
#define XCD_BAR_WORDS 3456
#define XB_SPIN_CAP (1u << 21)

__device__ __forceinline__ unsigned xb_ld(unsigned* p)              { return __hip_atomic_load(p, __ATOMIC_RELAXED, __HIP_MEMORY_SCOPE_AGENT); }
__device__ __forceinline__ unsigned xb_add(unsigned* p, unsigned v) { return __hip_atomic_fetch_add(p, v, __ATOMIC_RELAXED, __HIP_MEMORY_SCOPE_AGENT); }
__device__ __forceinline__ unsigned xb_xcc_id() { return (unsigned)__builtin_amdgcn_s_getreg((3 << 11) | 20) & 0xFu; }
#define XB_SPIN(cond, bar) do { unsigned _sp = 0; while (cond) { __builtin_amdgcn_s_sleep(1); \
    if ((++_sp & 255u) == 0u) { if (xb_ld(&(bar)[XB_TMO])) break; if (_sp > XB_SPIN_CAP) { atomicAdd(&(bar)[XB_TMO], 1u); break; } } } } while (0)

struct XcdBarrier {
    unsigned* bar; unsigned x;
    volatile LAS unsigned* st;
};

__device__ __forceinline__ XcdBarrier xcd_barrier_post(unsigned* bar, volatile LAS unsigned* st) {
    XcdBarrier b; b.bar = bar; b.x = xb_xcc_id(); b.st = st;
    if (threadIdx.x == 0) (void)xb_add(&bar[XB_XCNT(b.x)], 1u);
    return b;
}
__device__ __forceinline__ void xcd_barrier_complete(unsigned* bar, unsigned x, unsigned& nloc, unsigned& nx) {
    const unsigned G = gridDim.x * gridDim.y * gridDim.z;
    unsigned sum, cnt, mine, sp = 0u;
    for (;;) {
        sum = 0u; cnt = 0u; mine = 0u;
#pragma unroll
        for (unsigned j = 0; j < 16; ++j) { const unsigned c = xb_ld(&bar[XB_XCNT(j)]); sum += c; cnt += (c > 0u) ? 1u : 0u; mine = (j == x) ? c : mine; }
        if (sum == G) break;
        __builtin_amdgcn_s_sleep(1);
        if ((++sp & 255u) == 0u) { if (xb_ld(&bar[XB_TMO])) break; if (sp > XB_SPIN_CAP) { atomicAdd(&bar[XB_TMO], 1u); break; } }
    }
    nloc = mine > 0u ? mine : 1u; nx = cnt > 0u ? cnt : 1u;
}

__device__ __forceinline__ void xcd_barrier(const XcdBarrier& b) {
    asm volatile("s_waitcnt vmcnt(0)" ::: "memory");
    __syncthreads();
    if (threadIdx.x == 0) {
        unsigned* bar = b.bar;
        __builtin_amdgcn_s_waitcnt(0);
        unsigned nloc = b.st[0], nx = b.st[1];
        if (nloc == 0u) { xcd_barrier_complete(bar, b.x, nloc, nx); b.st[0] = nloc; b.st[1] = nx; }
        const unsigned old = xb_add(&bar[XB_XSUB(b.x)], 1u);
        const unsigned gen = old / nloc;
        if (old + 1u == (gen + 1u) * nloc) {
            __builtin_amdgcn_fence(__ATOMIC_RELEASE, "agent");
            asm volatile("s_waitcnt vmcnt(0)" ::: "memory");
            const unsigned og = xb_add(&bar[XB_TOP], 1u);
            const unsigned tg = og / nx;
            if (og + 1u == (tg + 1u) * nx) xb_add(&bar[XB_TOPGEN], 1u);
            else XB_SPIN(xb_ld(&bar[XB_TOPGEN]) == tg, bar);
            __builtin_amdgcn_fence(__ATOMIC_ACQUIRE, "agent");
            xb_add(&bar[XB_XGEN(b.x)], 1u);
            asm volatile("s_waitcnt vmcnt(0)" ::: "memory");
        } else {
            XB_SPIN(xb_ld(&bar[XB_XGEN(b.x)]) == gen, bar);
            __builtin_amdgcn_fence(__ATOMIC_ACQUIRE, "agent");
            asm volatile("s_waitcnt vmcnt(0)" ::: "memory");
        }
    }
    __syncthreads();
}

#ifndef PROBE_DUP
#define PROBE_DUP 0
#endif

DI void nsa_prep_phase(KP p, int l, int lane, int gw, int NGW, bool dry = false) {
    bf16_t* P1 = (bf16_t*)(p->ws + OFF_P1);
    bf16_t* VsT = (bf16_t*)(p->ws + OFF_VT); bf16_t* VwT = VsT + (size_t)NB * 2 * 64 * S;
    const float wq = p->in[4][l * 64 + lane], wk = p->in[5][l * 64 + lane];
    const float inv = rope_inv_freq(lane & 31);
    for (int task = gw; task < M / 8; task += NGW) {
        const int tok0 = task * 8, b = tok0 / S, t0 = tok0 % S;
        unsigned vpk[4][4];
#pragma unroll
        for (int tt = 0; tt < 8; ++tt) {
            bf16_t* row = P1 + (size_t)(tok0 + tt) * LDP;
            float sn, cs; sincos_rad((float)(t0 + tt) * inv, &sn, &cs);
            if (lane < 32) sn = -sn;
#pragma unroll
            for (int h = 0; h < 8; ++h) {
                const float x = bf2f(row[C_Q + h * 64 + lane]);
                const float y = x * rsqrtf(wave_sum(x * x) * (1.f / 64.f) + EPS) * wq;
                const float pr = __shfl_xor(y, 32);
                if (!dry) row[C_Q + h * 64 + lane] = f2bf((y * cs + pr * sn) * (0.125f * 1.4426950408889634f));
            }
#pragma unroll
            for (int v = 0; v < 4; ++v) {
                const int col = ((v < 2) ? C_KS : C_KW) + (v & 1) * 64 + lane;
                const float x = bf2f(row[col]);
                const float y = x * rsqrtf(wave_sum(x * x) * (1.f / 64.f) + EPS) * wk;
                const float pr = __shfl_xor(y, 32);
                if (!dry) row[col] = f2bf(y * cs + pr * sn);
            }
#pragma unroll
            for (int v = 0; v < 4; ++v) {
                const unsigned val = row[((v < 2) ? C_VS : C_VW) + (v & 1) * 64 + lane];
                if (tt & 1) vpk[v][tt >> 1] |= val << 16; else vpk[v][tt >> 1] = val;
            }
        }
#pragma unroll
        for (int v = 0; v < 4; ++v) {
            bf16_t* dst = ((v < 2) ? VsT : VwT) + ((size_t)(b * 2 + (v & 1)) * 64 + lane) * S + t0;
            if (!dry) *(u32x4*)dst = (u32x4){vpk[v][0], vpk[v][1], vpk[v][2], vpk[v][3]};
        }
    }
}
DI void memkv_post_phase(KP p, int l, int wave, int lane, int bid, int nblk) {
    bf16_t* KV = (bf16_t*)(p->ws + SM_KVX); bf16_t* XVT = (bf16_t*)(p->ws + SM_XVT);
    const float w0 = p->in[30][l * 128 + lane], w1 = p->in[30][l * 128 + 64 + lane];
    for (int bt = bid; bt < 32; bt += nblk) {
        const int b = bt >> 4, h = (bt >> 2) & 3, key0 = (bt & 3) * 64 + wave * 8;
        unsigned v0[4], v1[4];
#pragma unroll
        for (int i = 0; i < 8; ++i) {
            const int tok = b * 256 + key0 + i;
            bf16_t* kr = KV + (size_t)tok * 1024 + h * 128;
            const float x0 = bf2f(kr[lane]), x1 = bf2f(kr[64 + lane]);
            const float r = rsqrtf(wave_sum(x0 * x0 + x1 * x1) * (1.f / 128.f) + EPS);
            kr[lane] = f2bf(x0 * r * w0); kr[64 + lane] = f2bf(x1 * r * w1);
            const bf16_t* vr = KV + (size_t)tok * 1024 + 512 + h * 128;
            const unsigned a0 = vr[lane], a1 = vr[64 + lane];
            if (i & 1) { v0[i >> 1] |= a0 << 16; v1[i >> 1] |= a1 << 16; } else { v0[i >> 1] = a0; v1[i >> 1] = a1; }
        }
        *(u32x4*)(XVT + ((size_t)(b * 4 + h) * 128 + lane) * 256 + key0) = (u32x4){v0[0], v0[1], v0[2], v0[3]};
        *(u32x4*)(XVT + ((size_t)(b * 4 + h) * 128 + 64 + lane) * 256 + key0) = (u32x4){v1[0], v1[1], v1[2], v1[3]};
    }
}
DI void nsa_compress_phase(KP p, int l, LAS unsigned char* lds, int wave, int lane, int gw, int NGW) {
    const bf16_t* P1 = (const bf16_t*)(p->ws + OFF_P1); const bf16_t* W = (const bf16_t*)(p->ws + OFF_W);
    bf16_t* Kc = (bf16_t*)(p->ws + SM_KC); bf16_t* VcT = (bf16_t*)(p->ws + SM_VCT); const float* cbv = (const float*)(p->ws + SM_CB);
    LAS bf16_t* Hl = (LAS bf16_t*)(lds + wave * 4096);
    const int r16 = lane & 15, quad = lane >> 4;
    for (int task = (gw >> 3) + (gw & 7) * (NGW >> 3); task < 512; task += NGW) {
        const int nt = task & 63, kv = (task >> 6) & 1, g = (task >> 7) & 1, b = task >> 8, n0 = nt * 16;
        const bf16_t* w1 = W + (kv ? WT_C1V : WT_C1K); const bf16_t* w2 = W + (kv ? WT_C2V : WT_C2K);
        const int col0 = (kv ? C_VC : C_KC) + g * 64;
        f32x4 acc[4];
#pragma unroll
        for (int i = 0; i < 4; ++i) acc[i] = (f32x4){0.f, 0.f, 0.f, 0.f};
        const int nrow = n0 + r16;
#pragma unroll 4
        for (int ks = 0; ks < 64; ++ks) {
            const int j = ks >> 1, d = (ks & 1) * 32 + quad * 8; int tok = 16 * nrow + j; if (tok > S - 1) tok = S - 1;
            const bf16x8 a = ldg8(P1 + (size_t)(b * S + tok) * LDP + col0 + d);
#pragma unroll
            for (int c = 0; c < 4; ++c) { const bf16x8 bb = ldg8(w1 + (size_t)(c * 16 + r16) * 2048 + ks * 32 + quad * 8); acc[c] = MFMA16(a, bb, acc[c]); }
        }
#pragma unroll
        for (int c = 0; c < 4; ++c) { const float bias = cbv[kv * 64 + c * 16 + r16];
#pragma unroll
            for (int j = 0; j < 4; ++j) Hl[(4 * quad + j) * 72 + c * 16 + r16] = f2bf(siluf(acc[c][j] + bias)); }
        f32x4 y[4];
#pragma unroll
        for (int i = 0; i < 4; ++i) y[i] = (f32x4){0.f, 0.f, 0.f, 0.f};
#pragma unroll
        for (int ks = 0; ks < 2; ++ks) { const bf16x8 a = lds8(Hl + r16 * 72 + ks * 32 + quad * 8);
#pragma unroll
            for (int c = 0; c < 4; ++c) { const bf16x8 bb = ldg8(w2 + (size_t)(c * 16 + r16) * 64 + ks * 32 + quad * 8); y[c] = MFMA16(a, bb, y[c]); } }
        if (kv == 0) {
            float ss[4];
#pragma unroll
            for (int j = 0; j < 4; ++j) { ss[j] = y[0][j] * y[0][j] + y[1][j] * y[1][j] + y[2][j] * y[2][j] + y[3][j] * y[3][j]; ss[j] = sum16(ss[j]); }
#pragma unroll
            for (int j = 0; j < 4; ++j) { const int n = n0 + 4 * quad + j; const float r = rsqrtf(ss[j] * (1.f / 64.f) + EPS);
#pragma unroll
                for (int c = 0; c < 2; ++c) { const int i = c * 16 + r16; const float inv = rope_inv_freq(i);
                    float sn, cs; sincos_rad((float)(16 * n + 31) * inv, &sn, &cs);
                    const float x1 = y[c][j] * r * p->in[5][l * 64 + i], x2 = y[c + 2][j] * r * p->in[5][l * 64 + 32 + i];
                    bf16_t* dst = Kc + ((size_t)(b * 2 + g) * 1024 + n) * 64;
                    const bool ok = n < 1023;
                    dst[i] = ok ? f2bf(x1 * cs - x2 * sn) : (bf16_t)0; dst[32 + i] = ok ? f2bf(x2 * cs + x1 * sn) : (bf16_t)0; } }
        } else {
#pragma unroll
            for (int c = 0; c < 4; ++c) { const int col = c * 16 + r16; const int nb4 = n0 + 4 * quad;
                u32x2 o; o.x = pk2(y[c][0], y[c][1]); o.y = pk2(y[c][2], (nb4 + 3 < 1023) ? y[c][3] : 0.f);
                *(u32x2*)(VcT + ((size_t)(b * 2 + g) * 64 + col) * 1024 + nb4) = o; }
        }
    }
}
template <int MODE, int PB, bool SB = false>
DI void nsa_stream(const bf16_t* kbase, size_t kpitch, const bf16_t* vbase, size_t vpitch, int blk0, int blk1,
                   LAS bf16_t* kvb, LAS bf16_t* Pl, const LAS unsigned* selm, LAS float* imp, int tid, int wave, int lane,
                   const bf16x8 (&qa)[2][2], const int (&tq)[2], const int (&nvq)[2], const float (&invc)[2][4], float mhat,
                   f32x4 (&acc)[2][4], float (&lsumv)[2][4]) {
    const int r16 = lane & 15, quad = lane >> 4, lkey = tid >> 3, lch = tid & 7;
    const int nb = blk1 - blk0 + 1;
    if (nb <= 0) return;
    const int nstep = (nb + PB - 1) / PB;
    const bf16_t* kg = kbase + (size_t)lkey * kpitch + lch * 8;
    const bf16_t* vg = vbase + (size_t)lkey * vpitch + lch * 8;
    bf16x8 kr[PB], vr[PB]; float lcol[2] = {0.f, 0.f};
#define NSA_STAGE_LOAD(step) { _Pragma("unroll") for (int bi = 0; bi < PB; ++bi) { int blk = blk0 + (step) * PB + bi; if (blk > blk1) blk = blk1; \
        kr[bi] = ldg8(kg + (size_t)blk * 64 * kpitch); if (MODE != 0) vr[bi] = ldg8(vg + blk * 64); } }
#define NSA_STAGE_WRITE(step) { LAS bf16_t* nb_ = kvb + (SB ? 0 : ((step) & 1) * (PB * 9216)); _Pragma("unroll") for (int bi = 0; bi < PB; ++bi) { \
        *(LAS bf16x8*)(nb_ + bi * 9216 + lkey * 72 + lch * 8) = kr[bi]; if (MODE != 0) *(LAS bf16x8*)(nb_ + bi * 9216 + 4608 + lkey * 72 + lch * 8) = vr[bi]; } }
    NSA_STAGE_LOAD(0);
    __syncthreads();
    NSA_STAGE_WRITE(0);
    if (nstep > 1) NSA_STAGE_LOAD(1);
    __syncthreads();
    for (int st = 0; st < nstep; ++st) {
        const LAS bf16_t* pb = kvb + (SB ? 0 : (st & 1) * (PB * 9216));
#pragma unroll
        for (int bi = 0; bi < PB; ++bi) {
            const int j = blk0 + st * PB + bi;
            if (j <= blk1) {
                const LAS bf16_t* Kl = pb + bi * 9216; const LAS bf16_t* Vl = Kl + 4608;
                bool nomask;
                if (MODE <= 1) nomask = (j * 64 + 63) < __builtin_amdgcn_readfirstlane(nvq[0]);
                else nomask = (j > blk0 || (MODE == 3)) && (j < blk1);
                bool bit[2] = {true, true};
                if (MODE == 3) {
#pragma unroll
                    for (int grp = 0; grp < 2; ++grp) { const unsigned w = selm[(wave * 8 + grp * 4 + (r16 >> 2)) * 8 + (j >> 5)]; bit[grp] = ((w >> (j & 31)) & 1u) != 0u; }
                }
                const bool act0 = (MODE != 3) || __builtin_amdgcn_ballot_w64(bit[0]) != 0ull, act1 = (MODE != 3) || __builtin_amdgcn_ballot_w64(bit[1]) != 0ull;
                if (act0 || act1) {
#pragma unroll
                    for (int kt = 0; kt < 4; ++kt) {
                        const int kp0 = j * 64 + kt * 16 + 4 * quad;
                        const LAS bf16_t* kp = Kl + (kt * 16 + r16) * 72 + quad * 8;
                        const bf16x8 kf0 = lds8(kp), kf1 = lds8(kp + 32);
#pragma unroll
                        for (int grp = 0; grp < 2; ++grp) if (grp == 0 ? act0 : act1) {
                            const float ci = (MODE == 3 && !bit[grp]) ? -1.0e30f : -mhat;
                            f32x4 s = (f32x4){ci, ci, ci, ci}; s = MFMA16(kf0, qa[grp][0], s); s = MFMA16(kf1, qa[grp][1], s);
                            float pj[4];
                            if (nomask) {
#pragma unroll
                                for (int jj = 0; jj < 4; ++jj) pj[jj] = __builtin_amdgcn_exp2f(s[jj]);
                            } else {
#pragma unroll
                                for (int jj = 0; jj < 4; ++jj) {
                                    const int kpos = kp0 + jj; bool vis;
                                    if (MODE <= 1) vis = kpos < nvq[grp];
                                    else if (MODE == 2) { const int dl = tq[grp] - kpos; vis = (dl >= 0) && (dl < 512); }
                                    else vis = bit[grp] && (kpos <= tq[grp]);
                                    pj[jj] = vis ? __builtin_amdgcn_exp2f(s[jj]) : 0.f;
                                }
                            }
                            if (MODE == 1) {
#pragma unroll
                                for (int jj = 0; jj < 4; ++jj) pj[jj] *= invc[grp][0];
                            }
                            if (MODE != 1) lcol[grp] += (pj[0] + pj[1]) + (pj[2] + pj[3]);
                            if (MODE != 0) *(LAS u32x2*)(Pl + (grp * 16 + r16) * 72 + kt * 16 + 4 * quad) = (u32x2){pk2(pj[0], pj[1]), pk2(pj[2], pj[3])};
                            if (MODE == 1) {
                                float v = 2.f * (pj[0] + pj[1] + pj[2]) + pj[3], sp = pj[3];
                                v = sum4(v); sp = sum4(sp);
                                if ((r16 & 3) == 0) {
                                    LAS float* ip = imp + (grp * 4 + (r16 >> 2)) * 256 + (kp0 >> 2);
                                    __hip_atomic_fetch_add(ip, v, __ATOMIC_RELAXED, __HIP_MEMORY_SCOPE_WORKGROUP);
                                    if ((kp0 >> 2) + 1 < 256) __hip_atomic_fetch_add(ip + 1, sp, __ATOMIC_RELAXED, __HIP_MEMORY_SCOPE_WORKGROUP);
                                }
                            }
                        }
                    }
                    if (MODE != 0) {
#pragma unroll
                        for (int ks = 0; ks < 2; ++ks) {
                            bf16x8 vf[4];
#pragma unroll
                            for (int dt = 0; dt < 4; ++dt) vf[dt] = lds8(Vl + (dt * 16 + r16) * 72 + ks * 32 + quad * 8);
                            if (act0) { const bf16x8 a0 = lds8(Pl + r16 * 72 + ks * 32 + quad * 8);
#pragma unroll
                                for (int dt = 0; dt < 4; ++dt) acc[0][dt] = MFMA16(a0, vf[dt], acc[0][dt]); }
                            if (act1) { const bf16x8 a1 = lds8(Pl + (16 + r16) * 72 + ks * 32 + quad * 8);
#pragma unroll
                                for (int dt = 0; dt < 4; ++dt) acc[1][dt] = MFMA16(a1, vf[dt], acc[1][dt]); }
                        }
                    }
                }
            }
        }
        if (SB) {
            __syncthreads();
            if (st + 1 < nstep) { NSA_STAGE_WRITE(st + 1); if (st + 2 < nstep) NSA_STAGE_LOAD(st + 2); }
            __syncthreads();
        } else {
            if (st + 1 < nstep) { NSA_STAGE_WRITE(st + 1); if (st + 2 < nstep) NSA_STAGE_LOAD(st + 2); }
            __syncthreads();
        }
    }
#undef NSA_STAGE_LOAD
#undef NSA_STAGE_WRITE
    if (MODE != 1) {
#pragma unroll
        for (int grp = 0; grp < 2; ++grp) { float t = lcol[grp]; t += __shfl_xor(t, 16); t += __shfl_xor(t, 32);
            if (MODE == 0) lsumv[grp][0] += t;
            else {
#pragma unroll
                for (int jj = 0; jj < 4; ++jj) { const float u = __shfl(t, 4 * quad + jj); lsumv[grp][jj] += (r16 == 0) ? u : 0.f; } } }
    }
}
DI void nsa_attn_phase(KP p, int l, LAS unsigned char* lds, int tid, int bid, int nblk, bool dry = false) {
    bf16_t* P1 = (bf16_t*)(p->ws + OFF_P1);
    const bf16_t* Kc = (const bf16_t*)(p->ws + SM_KC); const bf16_t* VcT = (const bf16_t*)(p->ws + SM_VCT);
    const bf16_t* VsT = (const bf16_t*)(p->ws + OFF_VT); const bf16_t* VwT = VsT + (size_t)NB * 2 * 64 * S;
    const int lane = tid & 63, wave = __builtin_amdgcn_readfirstlane(tid >> 6), r16 = lane & 15, quad = lane >> 4;
    LAS bf16_t* kvb = (LAS bf16_t*)lds;
    LAS bf16_t* Pl = (LAS bf16_t*)(lds + 73728 + wave * 4608);
    LAS unsigned* selm = (LAS unsigned*)(lds + 110592);
    LAS bf16_t* ocl = (LAS bf16_t*)(lds + 112640 + wave * 4096);
    LAS float* imp = (LAS float*)(wave < 4 ? lds + 36864 + wave * 8192 : lds + 112640 + (wave - 4) * 8192);
    const float mhat = 1.4426950408889634f * 8.0f * wave_max(fabsf(p->in[4][l * 64 + lane])) * wave_max(fabsf(p->in[5][l * 64 + lane]));
    for (int task = bid; task < 1024; task += nblk) {
        const int bg = task >> 8, r = task & 255, qt = (bg & 1) ? 255 - r : r, b = bg >> 1, g = bg & 1;
        const size_t rowb = (size_t)b * S; const int tb = qt * 64, t0 = tb + wave * 8;
        const bf16_t* kcb = Kc + (size_t)(b * 2 + g) * 1024 * 64; const bf16_t* vcb = VcT + (size_t)(b * 2 + g) * 64 * 1024;
        bf16x8 qa[2][2]; int tq[2], nvq[2];
#pragma unroll
        for (int grp = 0; grp < 2; ++grp) { const bf16_t* qp = P1 + (rowb + t0 + grp * 4 + (r16 >> 2)) * LDP + C_Q + (g * 4 + (r16 & 3)) * 64 + quad * 8; qa[grp][0] = ldg8(qp); qa[grp][1] = ldg8(qp + 32);
            tq[grp] = t0 + grp * 4 + (r16 >> 2); nvq[grp] = tq[grp] >= 31 ? ((tq[grp] - 31) >> 4) + 1 : 0; }
        const int tl = tb + 63; const int nvt = tl >= 31 ? ((tl - 31) >> 4) + 1 : 0;
        const int cblk1 = nvt > 0 ? ((nvt - 1) >> 6) : -1;
        f32x4 acc[2][4]; float lsv[2][4], invc[2][4];
#pragma unroll
        for (int grp = 0; grp < 2; ++grp)
#pragma unroll
            for (int i = 0; i < 4; ++i) { acc[grp][i] = (f32x4){0.f, 0.f, 0.f, 0.f}; lsv[grp][i] = 0.f; invc[grp][i] = 0.f; }
        nsa_stream<0, 1>(kcb, 64, vcb, 1024, 0, cblk1, kvb, Pl, selm, imp, tid, wave, lane, qa, tq, nvq, invc, mhat, acc, lsv);
#pragma unroll
        for (int grp = 0; grp < 2; ++grp) { const float t = lsv[grp][0]; invc[grp][0] = t > 0.f ? 1.0f / t : 0.f; lsv[grp][0] = 0.f; }
        for (int i = lane; i < 2048; i += 64) imp[i] = 0.f;
        nsa_stream<1, 1>(kcb, 64, vcb, 1024, 0, cblk1, kvb, Pl, selm, imp, tid, wave, lane, qa, tq, nvq, invc, mhat, acc, lsv);
        const int cur = qt;
        {
            const int nf = cur >= 2 ? 3 : (cur >= 1 ? 2 : 1);
            int need = cur - 2; if (need < 0) need = 0; if (need > 16 - nf) need = 16 - nf;
            for (int qi = 0; qi < 2; ++qi) {
                unsigned long long kk[4][4], T[4] = {0ull, 0ull, 0ull, 0ull};
#pragma unroll
                for (int u = 0; u < 4; ++u)
#pragma unroll
                    for (int i = 0; i < 4; ++i) { const int j = i * 64 + lane; const bool cand = (j >= 1) && (j <= cur - 2);
                        kk[u][i] = cand ? ((((unsigned long long)__float_as_uint(imp[(qi + 2 * u) * 256 + j])) << 8) | (unsigned long long)(255 - j)) : 0ull; }
                if (need > 0) {
                    for (int bit = 39; bit >= 0; --bit) {
#pragma unroll
                        for (int u = 0; u < 4; ++u) {
                            const unsigned long long c = T[u] | (1ull << bit);
                            const int n = __builtin_popcountll(__builtin_amdgcn_ballot_w64(kk[u][0] >= c)) + __builtin_popcountll(__builtin_amdgcn_ballot_w64(kk[u][1] >= c))
                                        + __builtin_popcountll(__builtin_amdgcn_ballot_w64(kk[u][2] >= c)) + __builtin_popcountll(__builtin_amdgcn_ballot_w64(kk[u][3] >= c));
                            if (n >= need) T[u] = c;
                        }
                    }
                }
#pragma unroll
                for (int u = 0; u < 4; ++u) {
                    unsigned long long mb[4];
#pragma unroll
                    for (int i = 0; i < 4; ++i) mb[i] = (need > 0) ? __builtin_amdgcn_ballot_w64(kk[u][i] >= T[u] && kk[u][i] != 0ull) : 0ull;
                    if (lane == 0) {
                        unsigned wv[8];
#pragma unroll
                        for (int i = 0; i < 4; ++i) { wv[2 * i] = (unsigned)mb[i]; wv[2 * i + 1] = (unsigned)(mb[i] >> 32); }
                        wv[0] |= 1u;
#pragma unroll
                        for (int w = 0; w < 8; ++w) { if (w == (cur >> 5)) wv[w] |= 1u << (cur & 31); if (cur >= 1 && w == ((cur - 1) >> 5)) wv[w] |= 1u << ((cur - 1) & 31); selm[(wave * 8 + qi + 2 * u) * 8 + w] = wv[w]; }
                    }
                }
            }
        }
        __syncthreads();
#pragma unroll
        for (int grp = 0; grp < 2; ++grp) {
            const bf16_t* orow = P1 + (rowb + t0 + grp * 4 + quad) * LDP;
#pragma unroll
            for (int j = 0; j < 4; ++j) { const float g0 = sigmf(bf2f(orow[C_NG + (g * 4 + j) * 3 + 0]));
#pragma unroll
                for (int dt = 0; dt < 4; ++dt) { ocl[grp * 1024 + (4 * quad + j) * 64 + dt * 16 + r16] = f2bf(g0 * acc[grp][dt][j]); acc[grp][dt][j] = 0.f; } lsv[grp][j] = 0.f; }
        }
        nsa_stream<2, 2>(P1 + rowb * LDP + C_KW + g * 64, LDP, VwT + (size_t)(b * 2 + g) * 64 * S, S, qt >= 8 ? qt - 8 : 0, qt, kvb, Pl, selm, imp, tid, wave, lane, qa, tq, nvq, invc, mhat, acc, lsv);
#pragma unroll
        for (int grp = 0; grp < 2; ++grp) {
            const bf16_t* orow = P1 + (rowb + t0 + grp * 4 + quad) * LDP;
#pragma unroll
            for (int j = 0; j < 4; ++j) { const float tsum = sum16(lsv[grp][j]); const float gw2 = tsum > 0.f ? sigmf(bf2f(orow[C_NG + (g * 4 + j) * 3 + 2])) / tsum : 0.f;
#pragma unroll
                for (int dt = 0; dt < 4; ++dt) { LAS bf16_t* op = ocl + grp * 1024 + (4 * quad + j) * 64 + dt * 16 + r16; *op = f2bf(bf2f(*op) + gw2 * acc[grp][dt][j]); acc[grp][dt][j] = 0.f; } lsv[grp][j] = 0.f; }
        }
        if (!(dry && PROBE_DUP == 4))
        nsa_stream<3, 4, true>(P1 + rowb * LDP + C_KS + g * 64, LDP, VsT + (size_t)(b * 2 + g) * 64 * S, S, 0, qt, kvb, Pl, selm, imp, tid, wave, lane, qa, tq, nvq, invc, mhat, acc, lsv);
#pragma unroll
        for (int grp = 0; grp < 2; ++grp) {
            bf16_t* orow = P1 + (rowb + t0 + grp * 4 + quad) * LDP;
#pragma unroll
            for (int j = 0; j < 4; ++j) { const int hd = g * 4 + j; const float tsum = sum16(lsv[grp][j]); const float iv = tsum > 0.f ? sigmf(bf2f(orow[C_NG + hd * 3 + 1])) / tsum : 0.f;
#pragma unroll
                for (int dt = 0; dt < 4; ++dt) if (!dry) orow[C_Q + hd * 64 + dt * 16 + r16] = f2bf(bf2f(ocl[grp * 1024 + (4 * quad + j) * 64 + dt * 16 + r16]) + acc[grp][dt][j] * iv); }
        }
        __syncthreads();
    }
}
#ifndef SSD_NO_YOFF
#define SSD_NO_YOFF 0
#endif

DI void ssd_dt(KP p, int l, const bf16_t* P1, size_t tok0, int g, LAS float* dtl, LAS float* acl, int tid) {
    const int hg = tid >> 7, s = tid & 127, hh = g * 4 + hg, lane = tid & 63;
    const float A = -__expf(p->in[16][l * 8 + hh]);
    const float x = bf2f(P1[(tok0 + s) * LDP + C_DT + hh]) + p->in[15][l * 8 + hh];
    const float dt = x > 20.f ? x : __logf(1.0f + __expf(x));
    const float a = dt * A;
    float v = a;
#pragma unroll
    for (int o = 1; o < 64; o <<= 1) { const float u = __shfl_up(v, o); if (lane >= o) v += u; }
    dtl[hg * 128 + s] = dt;
    if ((s & 63) == 63 && s < 64) acl[hg * 128 + 127] = v;
    __syncthreads();
    const float add = (s >= 64) ? acl[hg * 128 + 127] : 0.f;
    __syncthreads();
    acl[hg * 128 + s] = v + add;
    __syncthreads();
}
DI void ssd_conv16(KP p, int l, const bf16_t* P1, size_t tok0, int tchunk0, int cc, int s0, float* out) {
    const float* cw = p->in[13] + (size_t)l * 4 * 768; const float w0 = cw[cc], w1 = cw[768 + cc], w2 = cw[2 * 768 + cc], w3 = cw[3 * 768 + cc];
    const float bias = p->in[14][l * 768 + cc];
    const bf16_t* col = P1 + C_XBC + cc;
    float h0 = 0.f, h1 = 0.f, h2 = 0.f;
    if (tchunk0 + s0 - 3 >= 0) h0 = bf2f(col[(tok0 + s0 - 3) * LDP]);
    if (tchunk0 + s0 - 2 >= 0) h1 = bf2f(col[(tok0 + s0 - 2) * LDP]);
    if (tchunk0 + s0 - 1 >= 0) h2 = bf2f(col[(tok0 + s0 - 1) * LDP]);
#pragma unroll
    for (int i = 0; i < 16; ++i) {
        const float xc = bf2f(col[(tok0 + s0 + i) * LDP]);
        out[i] = siluf(bias + w0 * h0 + w1 * h1 + w2 * h2 + w3 * xc);
        h0 = h1; h1 = h2; h2 = xc;
    }
}
DI void ssd_local_phase(KP p, int l, LAS unsigned char* lds, int tid, int nblk, int bid) {
    const bf16_t* P1 = (const bf16_t*)(p->ws + OFF_P1); bf16_t* SST = (bf16_t*)(p->ws + OFF_SST); float* cdec = (float*)(p->ws + SM_CDEC);
    LAS float* dtl = (LAS float*)lds; LAS float* acl = dtl + 512; LAS float* wl = acl + 512;
    LAS bf16_t* xT = (LAS bf16_t*)(lds + 8192);
    LAS bf16_t* BT = xT + 256 * 136;
    const int wave = tid >> 6, lane = tid & 63, r16 = lane & 15, quad = lane >> 4;
    for (int task = bid; task < NB * 128 * 2; task += nblk) {
        const int c = task & 127, b = (task >> 7) & 1, g = task >> 8;     const size_t tok0 = (size_t)b * S + c * 128;
        ssd_dt(p, l, P1, tok0, g, dtl, acl, tid);
        { const int hg = tid >> 7, s = tid & 127; const float al = acl[hg * 128 + 127]; wl[hg * 128 + s] = dtl[hg * 128 + s] * __expf(al - acl[hg * 128 + s]);
          if (s == 0) cdec[(b * 128 + c) * 32 + g * 4 + hg] = __expf(al); }
        __syncthreads();
        for (int it = tid; it < 320 * 8; it += 512) {
            const int ci = it % 320, seg = it / 320;
            float cv[16]; const int cc = (ci < 256) ? (g * 256 + ci) : (512 + g * 64 + ci - 256);
            ssd_conv16(p, l, P1, tok0, c * 128, cc, seg * 16, cv);
            if (ci < 256) { const int hg = ci >> 6;
#pragma unroll
                for (int i = 0; i < 16; ++i) xT[ci * 136 + seg * 16 + i] = f2bf(cv[i] * wl[hg * 128 + seg * 16 + i]); }
            else { const int n = ci - 256;
#pragma unroll
                for (int i = 0; i < 16; ++i) BT[n * 136 + seg * 16 + i] = f2bf(cv[i]); }
        }
        __syncthreads();
        { const int hg = wave >> 1, hh = g * 4 + hg;
#pragma unroll
          for (int pi = 0; pi < 2; ++pi) { const int pt = (wave & 1) * 2 + pi;
            f32x4 acc[4];
#pragma unroll
            for (int i = 0; i < 4; ++i) acc[i] = (f32x4){0.f, 0.f, 0.f, 0.f};
#pragma unroll
            for (int ks = 0; ks < 4; ++ks) { const bf16x8 a = lds8(xT + (hg * 64 + pt * 16 + r16) * 136 + ks * 32 + quad * 8);
#pragma unroll
                for (int nt = 0; nt < 4; ++nt) acc[nt] = MFMA16(a, lds8(BT + (nt * 16 + r16) * 136 + ks * 32 + quad * 8), acc[nt]); }
            bf16_t* dst = SST + ((size_t)((b * 128 + c) * 8 + hh) * 64) * 64;
#pragma unroll
            for (int nt = 0; nt < 4; ++nt)
#pragma unroll
                for (int j = 0; j < 4; ++j) dst[(pt * 16 + 4 * quad + j) * 64 + nt * 16 + r16] = f2bf(acc[nt][j]); } }
        __syncthreads();
    }
}
DI void ssd_scan_phase(KP p, int gtid, int nthr, bool dry = false) {
    bf16_t* SST = (bf16_t*)(p->ws + OFF_SST); const float* cdec = (const float*)(p->ws + SM_CDEC);
    for (int idx = gtid; idx < NB * 8 * 4096; idx += nthr) {
        const int b = idx >> 15, hh = (idx >> 12) & 7, pn = idx & 4095; float h = 0.f;
        for (int c0 = 0; c0 < 128; c0 += 16) {
            float st[16], dc[16];
#pragma unroll
            for (int i = 0; i < 16; ++i) { const size_t a = ((size_t)((b * 128 + c0 + i) * 8 + hh) << 12) + pn; st[i] = bf2f(SST[a]); dc[i] = __hip_atomic_load(cdec + (b * 128 + c0 + i) * 32 + hh, __ATOMIC_RELAXED, __HIP_MEMORY_SCOPE_AGENT); }
#pragma unroll
            for (int i = 0; i < 16; ++i) { const size_t a = ((size_t)((b * 128 + c0 + i) * 8 + hh) << 12) + pn; if (!dry) SST[a] = f2bf(h); h = h * dc[i] + st[i]; }
        }
    }
}
DI void ssd_out_phase(KP p, int l, LAS unsigned char* lds, int tid, int nblk, int bid, bool dry = false) {
    bf16_t* P1 = (bf16_t*)(p->ws + OFF_P1); const bf16_t* SST = (const bf16_t*)(p->ws + OFF_SST);
    LAS float* dtl = (LAS float*)lds; LAS float* acl = dtl + 512;
    LAS bf16_t* Cl = (LAS bf16_t*)(lds + 4096);
    LAS bf16_t* cbl = Cl + 128 * 72;
    LAS bf16_t* xT = cbl + 128 * 136;
    LAS bf16_t* Bl = xT + 64 * 136;
    const int wave = tid >> 6, lane = tid & 63, r16 = lane & 15, quad = lane >> 4;
    LAS bf16_t* yb_l = xT + 64 * 136 + wave * (16 * 264);
    for (int task = bid; task < NB * 128 * 2; task += nblk) {
        const int c = task & 127, b = (task >> 7) & 1, g = task >> 8;     const size_t tok0 = (size_t)b * S + c * 128;
        ssd_dt(p, l, P1, tok0, g, dtl, acl, tid);
        for (int it = tid; it < 128 * 8; it += 512) {
            const int ci = it & 127, seg = it >> 7;
            float cv[16]; const int cc = (ci < 64) ? (512 + g * 64 + ci) : (640 + g * 64 + ci - 64);
            ssd_conv16(p, l, P1, tok0, c * 128, cc, seg * 16, cv);
            LAS bf16_t* dstl = (ci < 64) ? (Bl + ci) : (Cl + ci - 64);
#pragma unroll
            for (int i = 0; i < 16; ++i) dstl[(seg * 16 + i) * 72] = f2bf(cv[i]);
        }
        __syncthreads();
        { f32x4 acc[8];
#pragma unroll
          for (int i = 0; i < 8; ++i) acc[i] = (f32x4){0.f, 0.f, 0.f, 0.f};
#pragma unroll
          for (int ks = 0; ks < 2; ++ks) { const bf16x8 a = lds8(Cl + (16 * wave + r16) * 72 + ks * 32 + quad * 8);
#pragma unroll
              for (int st = 0; st < 8; ++st) acc[st] = MFMA16(a, lds8(Bl + (st * 16 + r16) * 72 + ks * 32 + quad * 8), acc[st]); }
#pragma unroll
          for (int st = 0; st < 8; ++st)
#pragma unroll
              for (int j = 0; j < 4; ++j) cbl[(16 * wave + 4 * quad + j) * 136 + st * 16 + r16] = f2bf(acc[st][j]); }
        float ssq[4] = {0.f, 0.f, 0.f, 0.f};
        for (int hg = 0; hg < 4; ++hg) {
            const int hh = g * 4 + hg;
            __syncthreads();
            { const int ci = tid & 63, seg = tid >> 6; float cv[16]; ssd_conv16(p, l, P1, tok0, c * 128, hh * 64 + ci, seg * 16, cv);
#pragma unroll
              for (int i = 0; i < 16; ++i) xT[ci * 136 + seg * 16 + i] = f2bf(cv[i]); }
            __syncthreads();
            f32x4 yd[4], yo[4];
#pragma unroll
            for (int i = 0; i < 4; ++i) { yd[i] = (f32x4){0.f, 0.f, 0.f, 0.f}; yo[i] = (f32x4){0.f, 0.f, 0.f, 0.f}; }
            const int trow = 16 * wave + r16; const float at = acl[hg * 128 + trow];
            for (int ks = 0; ks * 32 <= 16 * wave + 15; ++ks) {
                float f[8]; const bf16x8 cbv = lds8(cbl + trow * 136 + ks * 32 + quad * 8); unpack8(cbv, f);
#pragma unroll
                for (int i = 0; i < 8; ++i) { const int s = ks * 32 + quad * 8 + i; f[i] = (s <= trow) ? f[i] * __expf(at - acl[hg * 128 + s]) * dtl[hg * 128 + s] : 0.f; }
                const bf16x8 a = pack8(f);
#pragma unroll
                for (int pt = 0; pt < 4; ++pt) yd[pt] = MFMA16(a, lds8(xT + (pt * 16 + r16) * 136 + ks * 32 + quad * 8), yd[pt]); }
            const bf16_t* prev = SST + ((size_t)((b * 128 + c) * 8 + hh) * 64) * 64;
#pragma unroll
            for (int ks = 0; ks < (SSD_NO_YOFF ? 0 : 2); ++ks) { const bf16x8 a = lds8(Cl + trow * 72 + ks * 32 + quad * 8);
#pragma unroll
                for (int pt = 0; pt < 4; ++pt) yo[pt] = MFMA16(a, ldg8(prev + (size_t)(pt * 16 + r16) * 64 + ks * 32 + quad * 8), yo[pt]); }
            const float dsk = p->in[17][l * 8 + hh];
#pragma unroll
            for (int j = 0; j < 4; ++j) { const int t = 16 * wave + 4 * quad + j; const float ea = __expf(acl[hg * 128 + t]);
#pragma unroll
                for (int pt = 0; pt < 4; ++pt) { const int pp = pt * 16 + r16;
                    const float y = yd[pt][j] + yo[pt][j] * ea + bf2f(xT[pp * 136 + t]) * dsk;
                    const float z = bf2f(P1[(tok0 + t) * LDP + C_Z + hh * 64 + pp]); const bf16_t yb = f2bf(y * siluf(z)); const float yr = bf2f(yb);
                    ssq[j] += yr * yr; yb_l[(4 * quad + j) * 264 + hg * 64 + pp] = yb; } }
        }
#pragma unroll
        for (int j = 0; j < 4; ++j) ssq[j] = rsqrtf(sum16(ssq[j]) * (1.f / 256.f) + EPS);
        for (int hg = 0; hg < 4; ++hg)
#pragma unroll
            for (int j = 0; j < 4; ++j)
#pragma unroll
                for (int pt = 0; pt < 4; ++pt) { const int t = 16 * wave + 4 * quad + j, col = (g * 4 + hg) * 64 + pt * 16 + r16;
                    if (!dry) P1[(tok0 + t) * LDP + C_Z + col] = f2bf(bf2f(yb_l[(4 * quad + j) * 264 + hg * 64 + pt * 16 + r16]) * ssq[j] * p->in[18][l * 512 + col]); }
        __syncthreads();
    }
}
DI float hg_lb(KP p, int l, int idx) { if (l == 0) return 0.f; const float l0 = p->in[20][idx], l1 = p->in[20][512 + idx]; return 1.0f / (1.0f + __expf(l0 - l1)); }
constexpr int BLP = 132;
DI void hg_cumlog(const bf16_t* P1, size_t tok0, int h, float lb, LAS float* bl, LAS float* segtot, int tid, float* fr) {
    const int d = tid & 127, sq = tid >> 7; float run = 0.f; float loc[16];
#pragma unroll
    for (int i = 0; i < 16; ++i) { fr[i] = bf2f(P1[(tok0 + sq * 16 + i) * LDP + C_HF + h * 128 + d]); run += __logf(lb + (1.f - lb) * sigmf(fr[i])); loc[i] = run; }
    segtot[sq * 128 + d] = run;
    __syncthreads();
    float off = 0.f;
#pragma unroll
    for (int q = 0; q < 3; ++q) if (q < sq) off += segtot[q * 128 + d];
#pragma unroll
    for (int i = 0; i < 16; ++i) bl[(sq * 16 + i) * BLP + d] = loc[i] + off;
    __syncthreads();
}
DI void hg_local_phase(KP p, int l, LAS unsigned char* lds, int tid, int nblk, int bid) {
    const bf16_t* P1 = (const bf16_t*)(p->ws + OFF_P1); bf16_t* HST = (bf16_t*)(p->ws + OFF_HST); float* hdec = (float*)(p->ws + SM_HDEC);
    LAS float* bl = (LAS float*)lds; LAS float* segtot = bl + 64 * BLP;
    LAS bf16_t* kdT = (LAS bf16_t*)(lds + 35840); LAS bf16_t* vT = kdT + 128 * 72;
    const int wave = tid >> 6, lane = tid & 63, r16 = lane & 15, quad = lane >> 4;
    for (int task = bid; task < NB * 4 * 256; task += nblk) {
        const int c = task & 255, h = (task >> 8) & 3, b = task >> 10; const size_t tok0 = (size_t)b * S + c * 64;
        const int d = tid & 127, sq = tid >> 7; const float lb = hg_lb(p, l, h * 128 + d);
        float fr[16]; hg_cumlog(P1, tok0, h, lb, bl, segtot, tid, fr);
        { const float blast = bl[63 * BLP + d]; float kd[16]; unsigned vv[8];
#pragma unroll
          for (int i = 0; i < 16; ++i) kd[i] = (1.f - lb) * sigmf(-fr[i]) * __expf(blast - bl[(sq * 16 + i) * BLP + d]);
#pragma unroll
          for (int i = 0; i < 8; ++i) { const unsigned a = P1[(tok0 + sq * 16 + 2 * i) * LDP + C_HI + h * 128 + d], bb = P1[(tok0 + sq * 16 + 2 * i + 1) * LDP + C_HI + h * 128 + d]; vv[i] = a | (bb << 16); }
          LAS u32x4* kd4 = (LAS u32x4*)(kdT + d * 72 + sq * 16); kd4[0] = (u32x4){pk2(kd[0], kd[1]), pk2(kd[2], kd[3]), pk2(kd[4], kd[5]), pk2(kd[6], kd[7])};
          kd4[1] = (u32x4){pk2(kd[8], kd[9]), pk2(kd[10], kd[11]), pk2(kd[12], kd[13]), pk2(kd[14], kd[15])};
          LAS u32x4* v4 = (LAS u32x4*)(vT + d * 72 + sq * 16); v4[0] = (u32x4){vv[0], vv[1], vv[2], vv[3]}; v4[1] = (u32x4){vv[4], vv[5], vv[6], vv[7]};
          if (sq == 0) hdec[((size_t)((b * 4 + h) * 256 + c)) * 128 + d] = __expf(blast); }
        __syncthreads();
        { f32x4 acc[8];
#pragma unroll
          for (int i = 0; i < 8; ++i) acc[i] = (f32x4){0.f, 0.f, 0.f, 0.f};
#pragma unroll
          for (int ks = 0; ks < 2; ++ks) { const bf16x8 a = lds8(vT + (16 * wave + r16) * 72 + ks * 32 + quad * 8);
#pragma unroll
              for (int dt = 0; dt < 8; ++dt) acc[dt] = MFMA16(a, lds8(kdT + (dt * 16 + r16) * 72 + ks * 32 + quad * 8), acc[dt]); }
          bf16_t* dst = HST + ((size_t)((b * 4 + h) * 256 + c) << 14);
#pragma unroll
          for (int dt = 0; dt < 8; ++dt)
#pragma unroll
              for (int j = 0; j < 4; ++j) dst[(16 * wave + 4 * quad + j) * 128 + dt * 16 + r16] = f2bf(acc[dt][j]); }
        __syncthreads();
    }
}
DI void hg_scan_phase(KP p, int gtid, int nthr, bool dry = false) {
    bf16_t* HST = (bf16_t*)(p->ws + OFF_HST); const float* hdec = (const float*)(p->ws + SM_HDEC);
    for (int idx = gtid; idx < NB * 4 * 16384; idx += nthr) {
        const int bh = idx >> 14, ed = idx & 16383, d = ed & 127; float h = 0.f;
        for (int c0 = 0; c0 < 256; c0 += 16) {
            float st[16], dc[16];
#pragma unroll
            for (int i = 0; i < 16; ++i) { const size_t a = ((size_t)(bh * 256 + c0 + i) << 14) + ed; st[i] = bf2f(HST[a]); dc[i] = __hip_atomic_load(hdec + (size_t)(bh * 256 + c0 + i) * 128 + d, __ATOMIC_RELAXED, __HIP_MEMORY_SCOPE_AGENT); }
#pragma unroll
            for (int i = 0; i < 16; ++i) { const size_t a = ((size_t)(bh * 256 + c0 + i) << 14) + ed; if (!dry) HST[a] = f2bf(h); h = h * dc[i] + st[i]; }
        }
    }
}
DI void hg_out_phase(KP p, int l, LAS unsigned char* lds, int tid, int nblk, int bid, bool dry = false) {
    bf16_t* P1 = (bf16_t*)(p->ws + OFF_P1); const bf16_t* HST = (const bf16_t*)(p->ws + OFF_HST);
    LAS float* bl = (LAS float*)lds; LAS float* segtot = bl + 64 * BLP;
    LAS bf16_t* vT = (LAS bf16_t*)(lds + 35840);
    LAS bf16_t* attl = (LAS bf16_t*)(lds + 54272);
    LAS float* ssl = (LAS float*)(lds + 72704);
    LAS float* lbl = ssl + 128;
    const int wave = tid >> 6, lane = tid & 63, r16 = lane & 15, quad = lane >> 4;
    for (int task = bid; task < NB * 4 * 256; task += nblk) {
        const int c = task & 255, h = (task >> 8) & 3, b = task >> 10; const size_t tok0 = (size_t)b * S + c * 64;
        const int d = tid & 127, sq = tid >> 7; const float lb = hg_lb(p, l, h * 128 + d);
        if (sq == 0) lbl[d] = lb;
        { unsigned vv[8];
#pragma unroll
          for (int i = 0; i < 8; ++i) { const unsigned a = P1[(tok0 + sq * 16 + 2 * i) * LDP + C_HI + h * 128 + d], bb = P1[(tok0 + sq * 16 + 2 * i + 1) * LDP + C_HI + h * 128 + d]; vv[i] = a | (bb << 16); }
          LAS u32x4* v4 = (LAS u32x4*)(vT + d * 72 + sq * 16); v4[0] = (u32x4){vv[0], vv[1], vv[2], vv[3]}; v4[1] = (u32x4){vv[4], vv[5], vv[6], vv[7]}; }
        float fr[16]; hg_cumlog(P1, tok0, h, lb, bl, segtot, tid, fr);
        const int I = wave & 3, eh = wave >> 2, trow = 16 * I + r16;
        f32x4 acc[4];
#pragma unroll
        for (int i = 0; i < 4; ++i) acc[i] = (f32x4){0.f, 0.f, 0.f, 0.f};
        f32x4 att[4];
#pragma unroll
        for (int i = 0; i < 4; ++i) att[i] = (f32x4){0.f, 0.f, 0.f, 0.f};
        const bf16_t* Sin = HST + ((size_t)((b * 4 + h) * 256 + c) << 14);
#pragma unroll
        for (int ks = 0; ks < 4; ++ks) {
            const int d0 = ks * 32 + quad * 8;
            float q[8], qi[8]; unpack8(ldg8(P1 + (tok0 + trow) * LDP + C_HQ + h * 128 + d0), q);
#pragma unroll
            for (int i = 0; i < 8; ++i) { const float qs = siluf(q[i]) * 0.08838834764831845f; const float bt = bl[trow * BLP + d0 + i]; const float br = I > 0 ? bl[(16 * I - 1) * BLP + d0 + i] : 0.f;
                q[i] = qs * __expf(bt); qi[i] = qs * __expf(bt - br); }
            const bf16x8 aq = pack8(q), aqi = pack8(qi);
#pragma unroll
            for (int et = 0; et < 4; ++et) acc[et] = MFMA16(aq, ldg8(Sin + (size_t)(eh * 64 + et * 16 + r16) * 128 + d0), acc[et]);
#pragma unroll
            for (int J = 0; J < 4; ++J) { if (J <= I) {
                const int srow = 16 * J + r16; float kf[8]; unpack8(ldg8(P1 + (tok0 + srow) * LDP + C_HF + h * 128 + d0), kf);
#pragma unroll
                for (int i = 0; i < 8; ++i) { const float br = I > 0 ? bl[(16 * I - 1) * BLP + d0 + i] : 0.f; const float ex = fminf(br - bl[srow * BLP + d0 + i], 60.f);
                    kf[i] = (1.f - lbl[d0 + i]) * sigmf(-kf[i]) * __expf(ex); }
                att[J] = MFMA16(aqi, pack8(kf), att[J]); } }
        }
        LAS bf16_t* al = attl + wave * 16 * 72;
#pragma unroll
        for (int J = 0; J < 4; ++J)
#pragma unroll
            for (int j = 0; j < 4; ++j) { float v = (J < I) ? att[J][j] : ((J == I && r16 <= 4 * quad + j) ? att[J][j] : 0.f); al[(4 * quad + j) * 72 + J * 16 + r16] = f2bf(v); }
#pragma unroll
        for (int ks = 0; ks < 2; ++ks) { if (ks * 32 <= 16 * I + 15) { const bf16x8 a = lds8(al + r16 * 72 + ks * 32 + quad * 8);
#pragma unroll
            for (int et = 0; et < 4; ++et) acc[et] = MFMA16(a, lds8(vT + (eh * 64 + et * 16 + r16) * 72 + ks * 32 + quad * 8), acc[et]); } }
#pragma unroll
        for (int j = 0; j < 4; ++j) { float s = acc[0][j] * acc[0][j] + acc[1][j] * acc[1][j] + acc[2][j] * acc[2][j] + acc[3][j] * acc[3][j]; s = sum16(s); if (r16 == 0) ssl[eh * 64 + 16 * I + 4 * quad + j] = s; }
        __syncthreads();
#pragma unroll
        for (int j = 0; j < 4; ++j) { const int t = 16 * I + 4 * quad + j; const float r = rsqrtf((ssl[t] + ssl[64 + t]) * (1.f / 128.f) + EPS);
#pragma unroll
            for (int et = 0; et < 4; ++et) { const int e = eh * 64 + et * 16 + r16; bf16_t* gp = P1 + (tok0 + t) * LDP + C_HG + h * 128 + e;
                const bf16_t ov = f2bf(acc[et][j] * r * p->in[21][l * 128 + e] * siluf(bf2f(*gp))); if (!dry) *gp = ov; } }
        __syncthreads();
    }
}
DI void xattn_phase(KP p, int l, LAS unsigned char* lds, int wave, int lane, int gw, int NGW, bool dry = false) {
    bf16_t* QX = (bf16_t*)(p->ws + OFF_P1); const bf16_t* KV = (const bf16_t*)(p->ws + SM_KVX); const bf16_t* XVT = (const bf16_t*)(p->ws + SM_XVT);
    LAS bf16_t* Pl = (LAS bf16_t*)(lds + wave * 8704);
    const int r16 = lane & 15, quad = lane >> 4;
    const float w0 = p->in[29][l * 128 + lane], w1 = p->in[29][l * 128 + 64 + lane], k0 = p->in[30][l * 128 + lane], k1 = p->in[30][l * 128 + 64 + lane];
    const float mhat = 11.32f * wave_max(fmaxf(fabsf(w0), fabsf(w1))) * wave_max(fmaxf(fabsf(k0), fabsf(k1)));
    for (int task = gw; task < (M / 16) * 4; task += NGW) {
        const int h = task & 3, tb = task >> 2; const size_t tok0 = (size_t)tb * 16; const int b = (int)(tok0 / S);
        bf16x8 qa[4]; float ss = 0.f; float qf[4][8];
#pragma unroll
        for (int ks = 0; ks < 4; ++ks) { unpack8(ldg8(QX + (tok0 + r16) * 512 + h * 128 + ks * 32 + quad * 8), qf[ks]);
#pragma unroll
            for (int i = 0; i < 8; ++i) ss += qf[ks][i] * qf[ks][i]; }
        ss += __shfl_xor(ss, 16); ss += __shfl_xor(ss, 32);
        const float r = rsqrtf(ss * (1.f / 128.f) + EPS) * 0.08838834764831845f;
#pragma unroll
        for (int ks = 0; ks < 4; ++ks) {
#pragma unroll
            for (int i = 0; i < 8; ++i) qf[ks][i] *= r * p->in[29][l * 128 + ks * 32 + quad * 8 + i];
            qa[ks] = pack8(qf[ks]); }
        float ls[4] = {0.f, 0.f, 0.f, 0.f};
        const bf16_t* kb = KV + (size_t)(b * 256) * 1024 + h * 128;
        for (int kt = 0; kt < 16; ++kt) {
            f32x4 s = (f32x4){0.f, 0.f, 0.f, 0.f};
#pragma unroll
            for (int ks = 0; ks < 4; ++ks) s = MFMA16(qa[ks], ldg8(kb + (size_t)(kt * 16 + r16) * 1024 + ks * 32 + quad * 8), s);
#pragma unroll
            for (int j = 0; j < 4; ++j) { const float pj = __expf(s[j] - mhat); ls[j] += pj; Pl[(4 * quad + j) * 264 + kt * 16 + r16] = f2bf(pj); }
        }
        f32x4 o[8];
#pragma unroll
        for (int i = 0; i < 8; ++i) o[i] = (f32x4){0.f, 0.f, 0.f, 0.f};
        const bf16_t* vb = XVT + (size_t)(b * 4 + h) * 128 * 256;
        for (int ks = 0; ks < 8; ++ks) { const bf16x8 a = lds8(Pl + r16 * 264 + ks * 32 + quad * 8);
#pragma unroll
            for (int dt = 0; dt < 8; ++dt) o[dt] = MFMA16(a, ldg8(vb + (size_t)(dt * 16 + r16) * 256 + ks * 32 + quad * 8), o[dt]); }
#pragma unroll
        for (int j = 0; j < 4; ++j) { const float iv = 1.0f / sum16(ls[j]);
#pragma unroll
            for (int dt = 0; dt < 8; ++dt) if (!dry) QX[(tok0 + 4 * quad + j) * 512 + h * 128 + dt * 16 + r16] = f2bf(o[dt][j] * iv); }
    }
}

constexpr int LDS_BYTES = 147456;
template <class Epi> DI void run_gemm(LAS unsigned char* lds, const bf16_t* A, int lda, const bf16_t* Bt, int ldb, int Mr, int N, int K, const Epi& E) {
    pg8::Gemm g{A, Bt, Mr, N, K, lda, ldb}; pg8::StaticOrder So; So.init(Mr, N, (int)gridDim.x, (int)blockIdx.x);
    pg8::gemm_phase<Epi, pg8::StaticOrder, true, true>(lds, g, So, E);
}
#ifndef NO_PREP
#define NO_PREP 0
#endif
#ifndef NO_NSA
#define NO_NSA 0
#endif
#ifndef NO_SSD
#define NO_SSD 0
#endif
#ifndef NO_HG
#define NO_HG 0
#endif
#ifndef NO_XA
#define NO_XA 0
#endif
#ifndef NO_SSD_MERGE
#define NO_SSD_MERGE 0
#endif
#ifndef FORCE_X1
#define FORCE_X1 0
#endif
#ifndef PROBE_DUP
#define PROBE_DUP 0
#endif
#define FIRST_X (NO_NSA ? (((NO_SSD && !FORCE_X1) || NO_SSD_MERGE) ? 2 : 1) : 0)
__global__ void __launch_bounds__(512, 2) mega_fwd(Params prm_unused) {
    extern __shared__ __attribute__((aligned(16))) unsigned char lds_raw[];
    LAS unsigned char* lds = (LAS unsigned char*)lds_raw;
    cg::grid_group grid = cg::this_grid();
    volatile LAS unsigned* xb_st = (volatile LAS unsigned*)(lds + LDS_BYTES - 16);
    if (threadIdx.x < 2) xb_st[threadIdx.x] = 0u;
    __syncthreads();
    const XcdBarrier xbar = xcd_barrier_post((unsigned*)(((KP)__builtin_amdgcn_kernarg_segment_ptr())->ws + SM_BAR), xb_st);
    bool first_sync = true;
#define GSYNC() do { if (first_sync) { grid.sync(); first_sync = false; } else xcd_barrier(xbar); } while (0)
    const KP kp = (KP)__builtin_amdgcn_kernarg_segment_ptr();
    const int G = gridDim.x, bid = blockIdx.x, NGW = G * 8, nthr = G * 512;
#define FRESH() KP p = kp; asm volatile("" : "+s"(p)); int tid = threadIdx.x; asm volatile("" : "+v"(tid)); \
    const int lane = tid & 63, wave = __builtin_amdgcn_readfirstlane(tid >> 6), gw = bid * 8 + wave, gtid = bid * 512 + tid; (void)lane; (void)wave; (void)gw; (void)gtid; \
    bf16_t* W = (bf16_t*)(p->ws + OFF_W); bf16_t* H = (bf16_t*)(p->ws + OFF_H); bf16_t* P1 = (bf16_t*)(p->ws + OFF_P1); bf16_t* MG = (bf16_t*)(p->ws + OFF_HST); (void)W; (void)H; (void)P1; (void)MG;
#pragma unroll
    for (int l = 0; l < DEPTH; ++l) {
#if !NO_PREP
        { FRESH(); prep_phase(p, l, lds, wave, lane, gw, NGW); }
#endif
#if PROBE_DUP == 6
        { FRESH(); prep_phase(p, l, lds, wave, lane, gw, NGW); }
#endif
        GSYNC();
        { FRESH(); run_gemm(lds, H, 1024, W + WT_IN, 1024, M, NIN1, 1024, pg8::EpiStore<0>{P1, LDP, NP1}); }
#if PROBE_DUP == 7
        { FRESH(); run_gemm(lds, H, 1024, W + WT_IN, 1024, M, NIN1, 1024, pg8::EpiStore<0>{P1, LDP, NP1}); }
#endif
        { FRESH(); run_gemm(lds, (const bf16_t*)(p->ws + SM_MN), 1024, W + WT_XKV, 1024, 512, 1024, 1024, pg8::EpiStore<0>{(bf16_t*)(p->ws + SM_KVX), 1024, 1024}); }
        GSYNC();
#if PROBE_DUP == 8
        { FRESH(); nsa_prep_phase(p, l, lane, gw, NGW, p->out != nullptr); }
#endif
#if !NO_NSA
        { FRESH(); nsa_prep_phase(p, l, lane, gw, NGW); }
#endif
#if !NO_XA
        { FRESH(); memkv_post_phase(p, l, wave, lane, bid, G); }
#endif
#if !NO_SSD
        { FRESH(); ssd_local_phase(p, l, lds, tid, G, bid); }
#endif
#if !NO_HG
        { FRESH(); hg_local_phase(p, l, lds, tid, G, bid); }
#endif
#if PROBE_DUP == 6
        { FRESH(); ssd_local_phase(p, l, lds, tid, G, bid); }
        { FRESH(); hg_local_phase(p, l, lds, tid, G, bid); }
#endif
        GSYNC();
#if !NO_NSA
        { FRESH(); nsa_compress_phase(p, l, lds, wave, lane, gw, NGW); }
#endif
#if PROBE_DUP == 6
        { FRESH(); nsa_compress_phase(p, l, lds, wave, lane, gw, NGW); }
#endif
#if PROBE_DUP == 8
        { FRESH(); ssd_scan_phase(p, gtid, nthr, p->out != nullptr); }
        { FRESH(); hg_scan_phase(p, gtid, nthr, p->out != nullptr); }
#endif
#if !NO_SSD
        { FRESH(); ssd_scan_phase(p, gtid, nthr); }
#endif
#if !NO_HG
        { FRESH(); hg_scan_phase(p, gtid, nthr); }
#endif
        GSYNC();
#if PROBE_DUP == 2
        { FRESH(); ssd_out_phase(p, l, lds, tid, G, bid, p->out != nullptr); }
        { FRESH(); hg_out_phase(p, l, lds, tid, G, bid, p->out != nullptr); }
#endif
#if PROBE_DUP == 1 || PROBE_DUP == 4
        { FRESH(); nsa_attn_phase(p, l, lds, tid, bid, G, p->out != nullptr); }
#endif
#if PROBE_DUP == 3
        { FRESH(); nsa_compress_phase(p, l, lds, wave, lane, gw, NGW); }
        { FRESH(); ssd_local_phase(p, l, lds, tid, G, bid); }
        { FRESH(); hg_local_phase(p, l, lds, tid, G, bid); }
        { FRESH(); prep_phase(p, l, lds, wave, lane, gw, NGW); }
#endif
#if !NO_SSD
        { FRESH(); ssd_out_phase(p, l, lds, tid, G, bid); }
#endif
#if !NO_HG
        { FRESH(); hg_out_phase(p, l, lds, tid, G, bid); }
#endif
#if !NO_NSA
        { FRESH(); nsa_attn_phase(p, l, lds, tid, bid, G); }
#endif
        GSYNC();
        { FRESH(); run_gemm(lds, H, 1024, W + WT_G, 1024, M, 2048, 1024, pg8::EpiStore<1>{P1 + C_SG, LDP, 2048}); }
#if PROBE_DUP == 7
        { FRESH(); run_gemm(lds, H, 1024, W + WT_G, 1024, M, 2048, 1024, pg8::EpiStore<1>{P1 + C_SG, LDP, 2048}); }
#endif
        { FRESH(); run_gemm(lds, H, 1024, W + WT_G + (size_t)2048 * 1024, 1024, M, 1024, 1024, pg8::EpiStore<1>{MG, 1024, 1024}); }
#if PROBE_DUP == 7
        { FRESH(); run_gemm(lds, H, 1024, W + WT_G + (size_t)2048 * 1024, 1024, M, 1024, 1024, pg8::EpiStore<1>{MG, 1024, 1024}); }
#endif
        GSYNC();
        { FRESH(); run_gemm(lds, P1 + C_Q, LDP, W + WT_NSAO, 512, M, 1024, 512, pg8::EpiMerge{P1 + C_SG, LDP, P1 + C_SG, LDP, 0}); }
        asm volatile("s_waitcnt vmcnt(0)" ::: "memory"); __builtin_amdgcn_fence(__ATOMIC_ACQUIRE, "agent"); __syncthreads();
        { FRESH(); run_gemm(lds, P1 + C_Z, LDP, W + WT_SSMO, 512, M, 1024, 512, pg8::EpiMerge{P1 + C_SG + 1024, LDP, P1 + C_SG, LDP, 1}); }
        asm volatile("s_waitcnt vmcnt(0)" ::: "memory"); __builtin_amdgcn_fence(__ATOMIC_ACQUIRE, "agent"); __syncthreads();
        { FRESH(); run_gemm(lds, P1 + C_HG, LDP, W + WT_HGO, 512, M, 1024, 512, pg8::EpiMerge{MG, 1024, P1 + C_SG, LDP, 1}); }
        GSYNC();
        { FRESH(); run_gemm(lds, P1 + C_SG, LDP, W + WT_OUT, 1024, M, 1024, 1024, pg8::EpiResid{(l == 0) ? p->in[0] : p->out, p->out, 1024}); }
        GSYNC();
        { FRESH(); rms_phase(p->out, p->in[24] + (size_t)l * 1024, H, M, gw, NGW, lane); }
#if PROBE_DUP == 6
        { FRESH(); rms_phase(p->out, p->in[24] + (size_t)l * 1024, H, M, gw, NGW, lane); }
#endif
        GSYNC();
        { FRESH(); run_gemm(lds, H, 1024, W + WT_XQ, 1024, M, 512, 1024, pg8::EpiStore<0>{P1, 512, 512}); }
#if PROBE_DUP == 7
        { FRESH(); run_gemm(lds, H, 1024, W + WT_XQ, 1024, M, 512, 1024, pg8::EpiStore<0>{P1, 512, 512}); }
#endif
        GSYNC();
#if PROBE_DUP == 8
        { FRESH(); xattn_phase(p, l, lds, wave, lane, gw, NGW, p->out != nullptr); }
#endif
#if !NO_XA
        { FRESH(); xattn_phase(p, l, lds, wave, lane, gw, NGW); }
#endif
        GSYNC();
        { FRESH(); run_gemm(lds, P1, 512, W + WT_XO, 512, M, 1024, 512, pg8::EpiResid{p->out, p->out, 1024}); }
        GSYNC();
        { FRESH(); rms_phase(p->out, p->in[32] + (size_t)l * 1024, H, M, gw, NGW, lane); }
#if PROBE_DUP == 6
        { FRESH(); rms_phase(p->out, p->in[32] + (size_t)l * 1024, H, M, gw, NGW, lane); }
#endif
        GSYNC();
        { FRESH(); run_gemm(lds, H, 1024, W + WT_GU, 1024, M, 2 * FFH, 1024, pg8::EpiSwiglu{P1, FFH}); }
#if PROBE_DUP == 7
        { FRESH(); run_gemm(lds, H, 1024, W + WT_GU, 1024, M, 2 * FFH, 1024, pg8::EpiSwiglu{P1, FFH}); }
#endif
        GSYNC();
        { FRESH(); run_gemm(lds, P1, FFH, W + WT_DN, FFH, M, 1024, FFH, pg8::EpiResid{p->out, p->out, 1024}); }
        GSYNC();
    }
}

extern "C" void kernel_launch(void* const* d_in, const int* in_sizes, int n_in, void* d_out, int out_size, void* d_ws, size_t ws_size, hipStream_t stream) {
    static int grid = 0;
    if (grid == 0) {
        if (n_in != 36 || out_size != M * Dm || ws_size < WS_END) { fprintf(stderr, "kernel_launch: unexpected shapes: n_in %d out %d ws %zu (need %zu)\n", n_in, out_size, ws_size, (size_t)WS_END); grid = -1; return; }
        int dev = 0, cus = 0, per_cu = 0;
        hipGetDevice(&dev); hipDeviceGetAttribute(&cus, hipDeviceAttributeMultiprocessorCount, dev);
        if (hipFuncSetAttribute((const void*)mega_fwd, hipFuncAttributeMaxDynamicSharedMemorySize, LDS_BYTES) != hipSuccess) { fprintf(stderr, "kernel_launch: hipFuncSetAttribute failed\n"); grid = -1; return; }
        if (hipOccupancyMaxActiveBlocksPerMultiprocessor(&per_cu, (const void*)mega_fwd, 512, LDS_BYTES) != hipSuccess || per_cu < 1) { fprintf(stderr, "kernel_launch: occupancy query gave %d\n", per_cu); per_cu = 1; }
        (void)hipGetLastError();
        grid = cus * 1;
    }
    if (grid < 0) return;
    if (hipMemsetAsync((char*)d_ws + SM_BAR, 0, XCD_BAR_WORDS * 4, stream) != hipSuccess) { fprintf(stderr, "kernel_launch: memset of barrier words failed\n"); return; }
    Params prm{};
    for (int i = 0; i < 36; ++i) prm.in[i] = (const float*)d_in[i];
    prm.out = (float*)d_out; prm.ws = (unsigned char*)d_ws;
    void* args[] = {&prm};
    hipError_t e = hipLaunchCooperativeKernel((const void*)mega_fwd, dim3(grid), dim3(512), args, LDS_BYTES, stream);
    if (e != hipSuccess) fprintf(stderr, "cooperative launch failed: %s (grid %d)\n", hipGetErrorString(e), grid);
}
```

```cpp
#include <hip/hip_runtime.h>
#include <hip/hip_cooperative_groups.h>
#include <cstdio>
#include <cstdint>
namespace cg = cooperative_groups;
namespace pg8 {
#define PG8_LAS __attribute__((address_space(3)))
typedef unsigned short bf16_t;
typedef short bf16x8 __attribute__((ext_vector_type(8)));
typedef float f32x4 __attribute__((ext_vector_type(4)));
typedef unsigned u32x4 __attribute__((ext_vector_type(4)));
constexpr int BM = 256, BK = 64, HALF = 128, HTB = HALF * BK * 2  , STAGE_BYTES = 8 * HTB, NXCD = 8, WGM = 8;

__host__ __device__ __forceinline__ int lds_byte(int r, int c) { const int st = (r >> 4) * 2 + (c >> 5), rr = r & 15, cc = c & 31, ob = rr * 64 + cc * 2; return st * 1024 + (ob ^ (((ob >> 9) & 1) << 5)); }
__host__ __device__ __forceinline__ void stage_rc(int b, int& R, int& C) { const int st = b / 1024, sb = b % 1024, swz = sb ^ (((sb >> 9) & 1) << 5); R = (st >> 1) * 16 + swz / 64; C = (st & 1) * 32 + (swz % 64) / 2; }
__host__ __device__ __forceinline__ int perm32(int rho) { const int n = rho >> 4, i = rho & 15; return 8 * (i >> 2) + 4 * n + (i & 3); }

struct Unit { int pm, pn; };
struct Gemm { const bf16_t* A; const bf16_t* Bt; int M, N, K, lda, ldb; };

struct StaticOrder {
    int nM, nN, nwg, G, c;
    __host__ __device__ void init(int M, int N, int G_, int c_) { nM = M / BM; nN = N / BM; nwg = nM * nN; G = G_; c = c_; }
    __host__ __device__ bool next(int i, Unit& u) const {
        const long L = (long)i * G + c; if (L >= nwg) return false;
        int wgid = (int)L; { const int q = nwg / NXCD, r = nwg % NXCD, xcd = wgid % NXCD, off = wgid / NXCD; wgid = (xcd < r ? xcd * (q + 1) : r * (q + 1) + (xcd - r) * q) + off; }
        const int nig = WGM * nN, gid = wgid / nig, fm = gid * WGM, gsz = (nM - fm) < WGM ? (nM - fm) : WGM;
        u.pm = fm + ((wgid % nig) % gsz); u.pn = (wgid % nig) / gsz; return true;
    }
    __device__ __forceinline__ void a_ready(const Unit&) const {}
    __device__ __forceinline__ void done(const Unit&) const {}
};

typedef __bf16 bf16n2_t __attribute__((ext_vector_type(2)));
__device__ __forceinline__ unsigned cvt_pk_bf16(float lo, float hi) { bf16n2_t v; v.x = (__bf16)lo; v.y = (__bf16)hi; return __builtin_bit_cast(unsigned, v); }

typedef unsigned u32x2 __attribute__((ext_vector_type(2)));
__device__ __forceinline__ float sigm(float x) { return __builtin_amdgcn_rcpf(1.0f + __expf(-x)); }
template <int ACT> struct EpiStore {
    static constexpr bool PERM = true, AFTER_DRAIN = false;
    bf16_t* O; int ldc; int ncols;
    __device__ __forceinline__ void operator()(const f32x4 (&acc)[2][2][4][2], const Unit& u, int wr, int wc, int fr, int fq) const {
        const int row0 = u.pm * BM + wr * 64 + fr, col0 = u.pn * BM + wc * 32 + 8 * fq;
#pragma unroll
        for (int ai = 0; ai < 2; ++ai)
#pragma unroll
            for (int m = 0; m < 4; ++m) { bf16_t* rowp = O + (size_t)(row0 + ai * HALF + m * 16) * ldc;
#pragma unroll
                for (int bj = 0; bj < 2; ++bj) { const int c = col0 + bj * HALF; if (c < ncols) {
                    f32x4 v0 = acc[ai][bj][m][0], v1 = acc[ai][bj][m][1];
                    if (ACT == 1) { v0 = (f32x4){sigm(v0[0]), sigm(v0[1]), sigm(v0[2]), sigm(v0[3])}; v1 = (f32x4){sigm(v1[0]), sigm(v1[1]), sigm(v1[2]), sigm(v1[3])}; }
                    u32x4 w; w.x = cvt_pk_bf16(v0[0], v0[1]); w.y = cvt_pk_bf16(v0[2], v0[3]); w.z = cvt_pk_bf16(v1[0], v1[1]); w.w = cvt_pk_bf16(v1[2], v1[3]);
                    *(u32x4*)(rowp + c) = w; } } }
    }
};
struct EpiMerge {
    static constexpr bool PERM = true, AFTER_DRAIN = false;
    const bf16_t* SG; int ldsg; bf16_t* Mg; int ldm; int accum;
    __device__ __forceinline__ void operator()(const f32x4 (&acc)[2][2][4][2], const Unit& u, int wr, int wc, int fr, int fq) const {
        const int row0 = u.pm * BM + wr * 64 + fr, col0 = u.pn * BM + wc * 32 + 8 * fq;
#pragma unroll
        for (int ai = 0; ai < 2; ++ai)
#pragma unroll
            for (int m = 0; m < 4; ++m) { const size_t r = (size_t)(row0 + ai * HALF + m * 16);
#pragma unroll
                for (int bj = 0; bj < 2; ++bj) { const int c = col0 + bj * HALF;
                    const u32x4 s = *(const u32x4*)(SG + r * ldsg + c);
                    u32x4 o = (u32x4){0u, 0u, 0u, 0u}; if (accum) o = *(const u32x4*)(Mg + r * ldm + c);
                    const f32x4 v0 = acc[ai][bj][m][0], v1 = acc[ai][bj][m][1];
                    float f[8] = {v0[0], v0[1], v0[2], v0[3], v1[0], v1[1], v1[2], v1[3]};
                    unsigned sw[4] = {s.x, s.y, s.z, s.w}, ow[4] = {o.x, o.y, o.z, o.w}, rw[4];
#pragma unroll
                    for (int q = 0; q < 4; ++q) {
                        const float a = __uint_as_float(ow[q] << 16) + __uint_as_float(sw[q] << 16) * f[2 * q];
                        const float b = __uint_as_float(ow[q] & 0xffff0000u) + __uint_as_float(sw[q] & 0xffff0000u) * f[2 * q + 1];
                        rw[q] = cvt_pk_bf16(a, b); }
                    *(u32x4*)(Mg + r * ldm + c) = (u32x4){rw[0], rw[1], rw[2], rw[3]}; } }
    }
};
struct EpiResid {
    static constexpr bool PERM = false, AFTER_DRAIN = false;
    const float* base; float* out; int ldc;
    __device__ __forceinline__ void operator()(const f32x4 (&acc)[2][2][4][2], const Unit& u, int wr, int wc, int fr, int fq) const {
        const int row0 = u.pm * BM + wr * 64 + fr, col0 = u.pn * BM + wc * 32 + 4 * fq;
#pragma unroll
        for (int ai = 0; ai < 2; ++ai)
#pragma unroll
            for (int m = 0; m < 4; ++m) { const size_t off = (size_t)(row0 + ai * HALF + m * 16) * ldc + col0;
#pragma unroll
                for (int bj = 0; bj < 2; ++bj)
#pragma unroll
                    for (int n = 0; n < 2; ++n) { const f32x4 bs = *(const f32x4*)(base + off + bj * HALF + n * 16); *(f32x4*)(out + off + bj * HALF + n * 16) = bs + acc[ai][bj][m][n]; } }
    }
};
struct EpiSwiglu {
    static constexpr bool PERM = true, AFTER_DRAIN = false;
    bf16_t* O; int ldc;
    __device__ __forceinline__ void operator()(const f32x4 (&acc)[2][2][4][2], const Unit& u, int wr, int wc, int fr, int fq) const {
        const int row0 = u.pm * BM + wr * 64 + fr, col0 = u.pn * HALF + wc * 32 + 8 * fq;
#pragma unroll
        for (int ai = 0; ai < 2; ++ai)
#pragma unroll
            for (int m = 0; m < 4; ++m) { bf16_t* rowp = O + (size_t)(row0 + ai * HALF + m * 16) * ldc + col0;
                float h[8];
#pragma unroll
                for (int n = 0; n < 2; ++n)
#pragma unroll
                    for (int q = 0; q < 4; ++q) { const float g = acc[ai][0][m][n][q], up = acc[ai][1][m][n][q]; h[n * 4 + q] = g * sigm(g) * up; }
                u32x4 w; w.x = cvt_pk_bf16(h[0], h[1]); w.y = cvt_pk_bf16(h[2], h[3]); w.z = cvt_pk_bf16(h[4], h[5]); w.w = cvt_pk_bf16(h[6], h[7]);
                *(u32x4*)rowp = w; }
    }
};

template <class Epi, class Sched, bool ALIGN_EPI = false, bool SP2 = false>
__device__ __forceinline__ void gemm_phase(PG8_LAS unsigned char* lds, const Gemm g, const Sched& S, const Epi& E) {
    int tid_ = threadIdx.x; asm volatile("" : "+v"(tid_));
    const int tid = tid_, wid = __builtin_amdgcn_readfirstlane(tid >> 6), lane = tid & 63, wr = wid >> 2, wc = wid & 3, fr = lane & 15, fq = lane >> 4;
    const int K = g.K, nt = K / BK;
    unsigned voffA[2], voffB[2];
#pragma unroll
    for (int i = 0; i < 2; ++i) { int R, C; stage_rc(tid * 16 + i * 8192, R, C); const int Rb = Epi::PERM ? ((R & ~31) + perm32(R & 31)) : R;
        voffA[i] = (unsigned)(R * g.lda + C) * 2u; voffB[i] = (unsigned)(Rb * g.ldb + C) * 2u; }
    const size_t kstep = (size_t)(BK * 2);
    const size_t hstepA = (size_t)HALF * g.lda * 2, hstepB = (size_t)HALF * g.ldb * 2;
    const size_t tstepA = 2 * hstepA, tstepB = 2 * hstepB;
    const unsigned ldsw = (unsigned)wid * 1024u;
    const int aoff = lds_byte(wr * 64 + fr, fq * 8), boff = lds_byte(wc * 32 + fr, fq * 8);
#define PG8_SA(b, h) (((b) * 2 + (h)) * HTB)
#define PG8_SB(b, h) ((4 + (b) * 2 + (h)) * HTB)
#define PG8_STAGE(bufoff, gbase, voff) do { _Pragma("unroll") for (int _i = 0; _i < 2; ++_i) \
        __builtin_amdgcn_global_load_lds((const unsigned*)((const char*)(gbase) + (voff)[_i]), (PG8_LAS unsigned*)(lds + (bufoff) + ldsw + _i * 8192), 16, 0, 0); } while (0)
#define PG8_LDA(dst, b, h) do { _Pragma("unroll") for (int m = 0; m < 4; ++m) _Pragma("unroll") for (int k = 0; k < 2; ++k) dst[m][k] = *(const PG8_LAS bf16x8*)(lds + PG8_SA(b, h) + aoff + m * 2048 + k * 1024); } while (0)
#define PG8_LDB(dst, b, h) do { _Pragma("unroll") for (int n = 0; n < 2; ++n) _Pragma("unroll") for (int k = 0; k < 2; ++k) dst[n][k] = *(const PG8_LAS bf16x8*)(lds + PG8_SB(b, h) + boff + n * 2048 + k * 1024); } while (0)
#define PG8_MMA(ai, bj, At, Bt) do { __builtin_amdgcn_s_setprio(1); _Pragma("unroll") for (int m = 0; m < 4; ++m) _Pragma("unroll") for (int n = 0; n < 2; ++n) _Pragma("unroll") for (int k = 0; k < 2; ++k) \
        acc[ai][bj][m][n] = __builtin_amdgcn_mfma_f32_16x16x32_bf16(Bt[n][k], At[m][k], acc[ai][bj][m][n], 0, 0, 0); __builtin_amdgcn_s_setprio(0); } while (0)
#define PG8_WAIT_V(n) asm volatile("s_waitcnt vmcnt(" #n ")" ::: "memory")
#define PG8_WAIT_L(n) asm volatile("s_waitcnt lgkmcnt(" #n ")" ::: "memory")
#define PG8_BAR __builtin_amdgcn_s_barrier()
#define PG8_SCHED __builtin_amdgcn_sched_barrier(0)
    Unit cur, nxt; int ui = 0;
    if (!S.next(0, cur)) return;
    f32x4 acc[2][2][4][2];
#pragma unroll
    for (int a = 0; a < 2; ++a)
#pragma unroll
        for (int b = 0; b < 2; ++b)
#pragma unroll
            for (int m = 0; m < 4; ++m)
#pragma unroll
                for (int n = 0; n < 2; ++n) acc[a][b][m][n] = (f32x4){0.f, 0.f, 0.f, 0.f};
    bf16x8 At[4][2], B0[2][2], B1[2][2];
    const char* cA = (const char*)g.A + (size_t)cur.pm * tstepA; const char* cB = (const char*)g.Bt + (size_t)cur.pn * tstepB;
    S.a_ready(cur);
    if constexpr (SP2) {
        PG8_STAGE(PG8_SB(0, 0), cB, voffB); PG8_STAGE(PG8_SB(0, 1), cB + hstepB, voffB); PG8_STAGE(PG8_SA(0, 0), cA, voffA); PG8_STAGE(PG8_SA(0, 1), cA + hstepA, voffA);
        if (wr == 1) PG8_BAR;
        PG8_WAIT_V(2); PG8_BAR;
        PG8_STAGE(PG8_SB(1, 0), cB + kstep, voffB); PG8_STAGE(PG8_SA(1, 0), cA + kstep, voffA); PG8_STAGE(PG8_SB(1, 1), cB + hstepB + kstep, voffB);
        PG8_WAIT_V(6); PG8_BAR;
    } else {
        PG8_STAGE(PG8_SB(0, 0), cB, voffB); PG8_STAGE(PG8_SA(0, 0), cA, voffA); PG8_STAGE(PG8_SB(0, 1), cB + hstepB, voffB); PG8_STAGE(PG8_SA(0, 1), cA + hstepA, voffA);
        if (wr == 1) PG8_BAR;
        PG8_WAIT_V(4); PG8_BAR;
        PG8_STAGE(PG8_SB(1, 0), cB + kstep, voffB); PG8_STAGE(PG8_SA(1, 0), cA + kstep, voffA); PG8_STAGE(PG8_SB(1, 1), cB + hstepB + kstep, voffB);
        PG8_WAIT_V(6); PG8_BAR;
    }
    for (;;) {
        const bool has_next = S.next(ui + 1, nxt);
        const char* nA = has_next ? (const char*)g.A + (size_t)nxt.pm * tstepA : cA; const char* nB = has_next ? (const char*)g.Bt + (size_t)nxt.pn * tstepB : cB;
        for (int t = 0; t < nt; t += 2) {
            const bool last = (t == nt - 2);
            const char* a1 = cA + (size_t)(t + 1) * kstep;
            const char* a2 = last ? nA : cA + (size_t)(t + 2) * kstep; const char* b2 = last ? nB : cB + (size_t)(t + 2) * kstep;
            const char* a3 = a2 + kstep; const char* b3 = b2 + kstep;
            if (last && has_next) S.a_ready(nxt);
            if constexpr (SP2) {
            PG8_LDB(B0, 0, 0); PG8_LDB(B1, 0, 1); PG8_SCHED; PG8_LDA(At, 0, 0); PG8_STAGE(PG8_SA(1, 1), a1 + hstepA, voffA);
            PG8_WAIT_V(8); PG8_WAIT_L(0); PG8_BAR; PG8_MMA(0, 0, At, B0); PG8_MMA(0, 1, At, B1); PG8_BAR; PG8_SCHED;
            PG8_LDA(At, 0, 1); PG8_STAGE(PG8_SB(0, 0), b2, voffB); PG8_STAGE(PG8_SB(0, 1), b2 + hstepB, voffB); PG8_STAGE(PG8_SA(0, 0), a2, voffA);
            PG8_WAIT_V(8); PG8_WAIT_L(0); PG8_BAR; PG8_MMA(1, 0, At, B0); PG8_MMA(1, 1, At, B1); PG8_BAR; PG8_SCHED;
            PG8_LDB(B0, 1, 0); PG8_LDB(B1, 1, 1); PG8_SCHED; PG8_LDA(At, 1, 0); PG8_STAGE(PG8_SA(0, 1), a2 + hstepA, voffA);
            PG8_WAIT_V(8); PG8_WAIT_L(0); PG8_BAR; PG8_MMA(0, 0, At, B0); PG8_MMA(0, 1, At, B1); PG8_BAR; PG8_SCHED;
            PG8_LDA(At, 1, 1); PG8_STAGE(PG8_SB(1, 0), b3, voffB); PG8_STAGE(PG8_SB(1, 1), b3 + hstepB, voffB); PG8_STAGE(PG8_SA(1, 0), a3, voffA);
            PG8_WAIT_V(8); PG8_WAIT_L(0); PG8_BAR; PG8_MMA(1, 0, At, B0); PG8_MMA(1, 1, At, B1); PG8_BAR; PG8_SCHED;
            } else {
            PG8_LDB(B0, 0, 0); PG8_SCHED; PG8_LDA(At, 0, 0); PG8_STAGE(PG8_SA(1, 1), a1 + hstepA, voffA);
            PG8_WAIT_L(8); PG8_BAR; PG8_WAIT_L(0); PG8_MMA(0, 0, At, B0); PG8_BAR; PG8_SCHED;
            PG8_LDB(B1, 0, 1); PG8_STAGE(PG8_SB(0, 0), b2, voffB);
            PG8_BAR; PG8_WAIT_L(0); PG8_MMA(0, 1, At, B1); PG8_BAR;
            PG8_LDA(At, 0, 1); PG8_STAGE(PG8_SA(0, 0), a2, voffA);
            PG8_BAR; PG8_WAIT_L(0); PG8_MMA(1, 0, At, B0); PG8_BAR; PG8_SCHED;
            PG8_STAGE(PG8_SB(0, 1), b2 + hstepB, voffB);
            PG8_WAIT_V(6); PG8_BAR; PG8_MMA(1, 1, At, B1); PG8_BAR;
            PG8_LDB(B0, 1, 0); PG8_SCHED; PG8_LDA(At, 1, 0); PG8_STAGE(PG8_SA(0, 1), a2 + hstepA, voffA);
            PG8_WAIT_L(8); PG8_BAR; PG8_WAIT_L(0); PG8_MMA(0, 0, At, B0); PG8_BAR; PG8_SCHED;
            PG8_LDB(B1, 1, 1); PG8_STAGE(PG8_SB(1, 0), b3, voffB);
            PG8_BAR; PG8_WAIT_L(0); PG8_MMA(0, 1, At, B1); PG8_BAR;
            PG8_LDA(At, 1, 1); PG8_STAGE(PG8_SA(1, 0), a3, voffA);
            PG8_BAR; PG8_WAIT_L(0); PG8_MMA(1, 0, At, B0); PG8_BAR; PG8_SCHED;
            PG8_STAGE(PG8_SB(1, 1), b3 + hstepB, voffB);
            PG8_WAIT_V(6); PG8_BAR; PG8_MMA(1, 1, At, B1); PG8_BAR;
            }
        }
        if constexpr (ALIGN_EPI) { if (wr == 0) PG8_BAR; }
        if constexpr (!Epi::AFTER_DRAIN) { E(acc, cur, wr, wc, fr, fq); S.done(cur); }
        if (!has_next) break;
#pragma unroll
        for (int a = 0; a < 2; ++a)
#pragma unroll
            for (int b = 0; b < 2; ++b)
#pragma unroll
                for (int m = 0; m < 4; ++m)
#pragma unroll
                    for (int n = 0; n < 2; ++n) acc[a][b][m][n] = (f32x4){0.f, 0.f, 0.f, 0.f};
        cur = nxt; cA = nA; cB = nB; ++ui;
        if constexpr (ALIGN_EPI) { if (wr == 1) PG8_BAR; }
    }
    PG8_WAIT_V(0);
    if constexpr (!ALIGN_EPI) { if (wr == 0) PG8_BAR; }
    PG8_BAR;
    if constexpr (Epi::AFTER_DRAIN) { E.fused(acc, cur, wr, wc, fr, fq, lds, wid, lane); S.done(cur); }
#undef PG8_SA
#undef PG8_SB
#undef PG8_STAGE
#undef PG8_LDA
#undef PG8_LDB
#undef PG8_MMA
#undef PG8_WAIT_V
#undef PG8_WAIT_L
#undef PG8_BAR
#undef PG8_SCHED
}
}

#define DI __device__ __forceinline__
#define LAS __attribute__((address_space(3)))
typedef unsigned short bf16_t;
typedef short bf16x8 __attribute__((ext_vector_type(8)));
typedef float f32x4 __attribute__((ext_vector_type(4)));
typedef unsigned u32x4 __attribute__((ext_vector_type(4)));
typedef unsigned u32x2 __attribute__((ext_vector_type(2)));
#define MFMA16(a, b, c) __builtin_amdgcn_mfma_f32_16x16x32_bf16((a), (b), (c), 0, 0, 0)

constexpr int Dm = 1024, NB = 2, S = 16384, M = NB * S, DEPTH = 2;
constexpr int LDP = 4672, NP1 = 4640, NIN1 = 4864, NGATE = 3072, FFH = 2816;
constexpr float EPS = 1e-6f;
constexpr int C_Q = 0, C_KC = 512, C_VC = 640, C_KS = 768, C_VS = 896, C_KW = 1024, C_VW = 1152, C_NG = 1280, C_Z = 1304, C_XBC = 1816, C_DT = 2584,
              C_HQ = 2592, C_HF = 3104, C_HI = 3616, C_HG = 4128, C_SG = 1856;
constexpr size_t WT_IN = 0, WT_G = WT_IN + (size_t)NIN1 * 1024, WT_NSAO = WT_G + (size_t)NGATE * 1024, WT_SSMO = WT_NSAO + 1024 * 512, WT_HGO = WT_SSMO + 1024 * 512,
                 WT_OUT = WT_HGO + 1024 * 512, WT_XQ = WT_OUT + 1024 * 1024, WT_XKV = WT_XQ + 512 * 1024, WT_XO = WT_XKV + 1024 * 1024, WT_GU = WT_XO + 1024 * 512,
                 WT_DN = WT_GU + (size_t)2 * FFH * 1024, WT_C1K = WT_DN + (size_t)1024 * FFH, WT_C2K = WT_C1K + 64 * 2048, WT_C1V = WT_C2K + 64 * 64, WT_C2V = WT_C1V + 64 * 2048,
                 WT_END = WT_C2V + 64 * 64;
constexpr size_t MiB = 1u << 20;
constexpr size_t OFF_W = 0, OFF_H = 42 * MiB, OFF_P1 = 106 * MiB, OFF_SST = 398 * MiB, OFF_HST = 414 * MiB, OFF_VT = 478 * MiB, OFF_SM = 494 * MiB;
static_assert(WT_END * 2 <= OFF_H, "weights fit");
static_assert(OFF_P1 + (size_t)M * LDP * 2 <= OFF_SST, "P1 fits");
constexpr size_t SM_KC = OFF_SM, SM_VCT = SM_KC + 512 * 1024, SM_MN = SM_VCT + 512 * 1024, SM_KVX = SM_MN + MiB, SM_XVT = SM_KVX + MiB, SM_CDEC = SM_XVT + 512 * 1024,
                 SM_HDEC = SM_CDEC + 64 * 1024, SM_CB = SM_HDEC + MiB, SM_BAR = SM_CB + 4096, WS_END = SM_BAR + 16384;

DI float bf2f(bf16_t v) { return __uint_as_float((unsigned)v << 16); }
typedef __bf16 bf16n2 __attribute__((ext_vector_type(2)));
DI unsigned pk2(float lo, float hi) { bf16n2 v; v.x = (__bf16)lo; v.y = (__bf16)hi; return __builtin_bit_cast(unsigned, v); }
DI bf16_t f2bf(float f) { return (bf16_t)(pk2(f, 0.f) & 0xffffu); }
DI float lo16(unsigned w) { return __uint_as_float(w << 16); }
DI float hi16(unsigned w) { return __uint_as_float(w & 0xffff0000u); }
template <int CTRL> DI float dpp_f(float v) { return __builtin_bit_cast(float, __builtin_amdgcn_update_dpp(0, __builtin_bit_cast(int, v), CTRL, 0xF, 0xF, true)); }
DI float sum4(float v) { v += dpp_f<0xB1>(v); v += dpp_f<0x4E>(v); return v; }
DI float sum16(float v) { v += dpp_f<0x128>(v); v += dpp_f<0x124>(v); return sum4(v); }
DI float xor16f(float x) { const unsigned u = __builtin_bit_cast(unsigned, x); auto r = __builtin_amdgcn_permlane16_swap(u, u, false, false); return __builtin_bit_cast(float, (threadIdx.x & 16) ? r[0] : r[1]); }
DI float xor32f(float x) { const unsigned u = __builtin_bit_cast(unsigned, x); auto r = __builtin_amdgcn_permlane32_swap(u, u, false, false); return __builtin_bit_cast(float, (threadIdx.x & 32) ? r[0] : r[1]); }
DI float wave_sum(float v) { v = sum16(v); v += xor16f(v); v += xor32f(v); return v; }
DI float wave_max(float v) {
#pragma unroll
    for (int o = 1; o < 64; o <<= 1) v = fmaxf(v, __shfl_xor(v, o));
    return v;
}
DI float sigmf(float x) { return __builtin_amdgcn_rcpf(1.0f + __expf(-x)); }
DI float siluf(float x) { return x * __builtin_amdgcn_rcpf(1.0f + __expf(-x)); }
DI bf16x8 ldg8(const bf16_t* p) { return *(const bf16x8*)p; }
DI bf16x8 lds8(const LAS bf16_t* p) { return *(const LAS bf16x8*)p; }
DI bf16x8 pack8(const float* f) { u32x4 w; w.x = pk2(f[0], f[1]); w.y = pk2(f[2], f[3]); w.z = pk2(f[4], f[5]); w.w = pk2(f[6], f[7]); return __builtin_bit_cast(bf16x8, w); }
DI void unpack8(bf16x8 v, float* f) { u32x4 w = __builtin_bit_cast(u32x4, v); f[0] = lo16(w.x); f[1] = hi16(w.x); f[2] = lo16(w.y); f[3] = hi16(w.y); f[4] = lo16(w.z); f[5] = hi16(w.z); f[6] = lo16(w.w); f[7] = hi16(w.w); }


DI void sincos_rad(float ang, float* sn, float* cs) {
    const float hi = ang * 0.15915494309189535f; const float lo = fmaf(ang, 0.15915494309189535f, -hi) + ang * 6.4206383266e-09f;
    const float fr = (hi - rintf(hi)) + lo;
    *sn = __builtin_amdgcn_sinf(fr); *cs = __builtin_amdgcn_cosf(fr);
}
DI float rope_inv_freq(int i) { return __builtin_amdgcn_exp2f(-(float)i * (13.287712379549449f / 32.0f)); }
struct Params { const float* in[36]; float* out; unsigned char* ws; };
typedef const __attribute__((address_space(4))) Params* KP;

DI void transpose_item(const float* W, int ld, int c0, int K, int N, bf16_t* WT, int mode, LAS float* scr, int item, int lane) {
    const int nblk = N / 32, kb = item / nblk, nb = item % nblk, k0 = 64 * kb, n0 = 32 * nb;
#pragma unroll 8
    for (int i = 0; i < 32; ++i) { const int kk = 2 * i + (lane >> 5); scr[kk * 33 + (lane & 31)] = W[(size_t)(k0 + kk) * ld + c0 + n0 + (lane & 31)]; }
    const int c = lane & 7;
#pragma unroll
    for (int j = 0; j < 4; ++j) { const int nl = (lane >> 3) + 8 * j; const LAS float* s = scr + (8 * c) * 33 + nl;
        u32x4 o; o.x = pk2(s[0 * 33], s[1 * 33]); o.y = pk2(s[2 * 33], s[3 * 33]); o.z = pk2(s[4 * 33], s[5 * 33]); o.w = pk2(s[6 * 33], s[7 * 33]);
        const int n = n0 + nl; int row = n; if (mode == 1) row = (n >> 7) * 256 + (n & 127); else if (mode == 2) row = (n >> 7) * 256 + 128 + (n & 127);
        *(u32x4*)(WT + (size_t)row * K + k0 + 8 * c) = o; }
}
DI void transpose_job(const float* W, int ld, int c0, int K, int N, bf16_t* WT, int mode, LAS float* scr, int gw, int NGW, int lane) {
    const int nitems = (K / 64) * (N / 32);
    for (int it = gw; it < nitems; it += NGW) transpose_item(W, ld, c0, K, N, WT, mode, scr, it, lane);
}
DI void rms_row(const float* xrow, const float* w, bf16_t* orow, int lane) {
    const f32x4* xr = (const f32x4*)xrow + lane; const f32x4* wr = (const f32x4*)w + lane;
    f32x4 v[4]; float s = 0.f;
#pragma unroll
    for (int j = 0; j < 4; ++j) { v[j] = xr[64 * j]; s += (v[j].x * v[j].x + v[j].y * v[j].y) + (v[j].z * v[j].z + v[j].w * v[j].w); }
    const float r = rsqrtf(wave_sum(s) * (1.f / 1024.f) + EPS);
    u32x2* o8 = (u32x2*)orow + lane;
#pragma unroll
    for (int j = 0; j < 4; ++j) { const f32x4 g = wr[64 * j]; u32x2 o; o.x = pk2(v[j].x * r * g.x, v[j].y * r * g.y); o.y = pk2(v[j].z * r * g.z, v[j].w * r * g.w); o8[64 * j] = o; }
}
DI void rms_phase(const float* x, const float* w, bf16_t* H, int nrows, int gw, int NGW, int lane) {
    const f32x4* wr = (const f32x4*)w + lane; f32x4 g[4];
#pragma unroll
    for (int j = 0; j < 4; ++j) g[j] = wr[64 * j];
    for (int m = gw; m < nrows; m += 2 * NGW) {
        const int m2 = m + NGW; const bool has2 = m2 < nrows; const int mm2 = has2 ? m2 : m;
        const f32x4* x0 = (const f32x4*)(x + (size_t)m * 1024) + lane; const f32x4* x1 = (const f32x4*)(x + (size_t)mm2 * 1024) + lane;
        f32x4 v0[4], v1[4]; float s0 = 0.f, s1 = 0.f;
#pragma unroll
        for (int j = 0; j < 4; ++j) { v0[j] = x0[64 * j]; v1[j] = x1[64 * j]; }
#pragma unroll
        for (int j = 0; j < 4; ++j) { s0 += (v0[j].x * v0[j].x + v0[j].y * v0[j].y) + (v0[j].z * v0[j].z + v0[j].w * v0[j].w); s1 += (v1[j].x * v1[j].x + v1[j].y * v1[j].y) + (v1[j].z * v1[j].z + v1[j].w * v1[j].w); }
        const float r0 = rsqrtf(wave_sum(s0) * (1.f / 1024.f) + EPS), r1 = rsqrtf(wave_sum(s1) * (1.f / 1024.f) + EPS);
        u32x2* o0 = (u32x2*)(H + (size_t)m * 1024) + lane; u32x2* o1 = (u32x2*)(H + (size_t)mm2 * 1024) + lane;
#pragma unroll
        for (int j = 0; j < 4; ++j) { u32x2 o; o.x = pk2(v0[j].x * r0 * g[j].x, v0[j].y * r0 * g[j].y); o.y = pk2(v0[j].z * r0 * g[j].z, v0[j].w * r0 * g[j].w); o0[64 * j] = o; }
        if (has2) {
#pragma unroll
            for (int j = 0; j < 4; ++j) { u32x2 o; o.x = pk2(v1[j].x * r1 * g[j].x, v1[j].y * r1 * g[j].y); o.y = pk2(v1[j].z * r1 * g[j].z, v1[j].w * r1 * g[j].w); o1[64 * j] = o; } }
    }
}


constexpr int NTJ = 17;
__device__ const int TJ_IN[NTJ]   = {3, 3, 12, 19, 22, 23, 26, 27, 28, 31, 33, 34, 35, 8, 9, 10, 11};
__device__ const int TJ_LD[NTJ]   = {7712, 7712, 1024, 1024, 1024, 1024, 512, 512, 512, 1024, FFH, FFH, 1024, 64, 64, 64, 64};
__device__ const int TJ_C0[NTJ]   = {0, 4640, 0, 0, 0, 0, 0, 0, 0, 0, 0, 0, 0, 0, 0, 0, 0};
__device__ const int TJ_K[NTJ]    = {1024, 1024, 512, 512, 512, 1024, 1024, 1024, 1024, 512, 1024, 1024, FFH, 2048, 64, 2048, 64};
__device__ const int TJ_N[NTJ]    = {4640, 3072, 1024, 1024, 1024, 1024, 512, 512, 512, 1024, FFH, FFH, 1024, 64, 64, 64, 64};
__device__ const int TJ_MODE[NTJ] = {0, 0, 0, 0, 0, 0, 0, 0, 0, 0, 1, 2, 0, 0, 0, 0, 0};
__device__ const unsigned TJ_WT[NTJ] = {(unsigned)WT_IN, (unsigned)WT_G, (unsigned)WT_NSAO, (unsigned)WT_SSMO, (unsigned)WT_HGO, (unsigned)WT_OUT, (unsigned)WT_XQ, (unsigned)WT_XKV, (unsigned)(WT_XKV + 512 * 1024),
                                        (unsigned)WT_XO, (unsigned)WT_GU, (unsigned)WT_GU, (unsigned)WT_DN, (unsigned)WT_C1K, (unsigned)WT_C2K, (unsigned)WT_C1V, (unsigned)WT_C2V};
DI void prep_phase(KP p, int l, LAS unsigned char* lds, int wave, int lane, int gw, int NGW) {
    bf16_t* W = (bf16_t*)(p->ws + OFF_W);
    LAS float* scr = (LAS float*)(lds + wave * 16384);
    { int tot = 0;
#pragma unroll
      for (int j = 0; j < NTJ; ++j) tot += (TJ_K[j] / 64) * (TJ_N[j] / 32);
      for (int it = gw; it < tot; it += NGW) {
        int r = it, j = 0;
#pragma unroll
        for (int q = 0; q < NTJ - 1; ++q) { const int n = (TJ_K[q] / 64) * (TJ_N[q] / 32); if (j == q && r >= n) { r -= n; j = q + 1; } }
        const float* src = p->in[TJ_IN[j]] + (size_t)l * TJ_K[j] * TJ_LD[j];
        transpose_item(src, TJ_LD[j], TJ_C0[j], TJ_K[j], TJ_N[j], W + TJ_WT[j], TJ_MODE[j], scr, r, lane);
      } }
    { u32x4* z = (u32x4*)(W + WT_IN + (size_t)4640 * 1024); const int n16 = 224 * 1024 * 2 / 16;
      for (int i = gw * 64 + lane; i < n16; i += NGW * 64) z[i] = (u32x4){0u, 0u, 0u, 0u}; }
    if (gw < 8) { float* cbv = (float*)(p->ws + SM_CB);
      for (int o = gw; o < 128; o += 8) { const int kv = o >> 6, c = o & 63; const float* pos = p->in[6 + kv] + (size_t)l * 2048; const float* w1 = p->in[kv ? 10 : 8] + (size_t)l * 2048 * 64;
        float s = 0.f; for (int i = lane; i < 2048; i += 64) s += pos[i] * w1[(size_t)i * 64 + c];
        s = wave_sum(s); if (lane == 0) cbv[o] = s; } }
    rms_phase(p->in[1], p->in[25] + (size_t)l * 1024, (bf16_t*)(p->ws + SM_MN), 512, gw, NGW, lane);
    rms_phase(l == 0 ? p->in[0] : p->out, p->in[2] + (size_t)l * 1024, (bf16_t*)(p->ws + OFF_H), M, gw, NGW, lane);
}
#define XB_TMO      128
#define XB_XCNT(j)  (256  + 64 * (j))
#define XB_XSUB(j)  (1280 + 64 * (j))
#define XB_XGEN(j)  (2304 + 64 * (j))
#define XB_TOP      3328
#define XB_TOPGEN   3392
#define XCD_BAR_WORDS 3456
#define XB_SPIN_CAP (1u << 21)

__device__ __forceinline__ unsigned xb_ld(unsigned* p)              { return __hip_atomic_load(p, __ATOMIC_RELAXED, __HIP_MEMORY_SCOPE_AGENT); }
__device__ __forceinline__ unsigned xb_add(unsigned* p, unsigned v) { return __hip_atomic_fetch_add(p, v, __ATOMIC_RELAXED, __HIP_MEMORY_SCOPE_AGENT); }
__device__ __forceinline__ unsigned xb_xcc_id() { return (unsigned)__builtin_amdgcn_s_getreg((3 << 11) | 20) & 0xFu; }
#define XB_SPIN(cond, bar) do { unsigned _sp = 0; while (cond) { __builtin_amdgcn_s_sleep(1); \
    if ((++_sp & 255u) == 0u) { if (xb_ld(&(bar)[XB_TMO])) break; if (_sp > XB_SPIN_CAP) { atomicAdd(&(bar)[XB_TMO], 1u); break; } } } } while (0)

struct XcdBarrier {
    unsigned* bar; unsigned x;
    volatile LAS unsigned* st;
};

__device__ __forceinline__ XcdBarrier xcd_barrier_post(unsigned* bar, volatile LAS unsigned* st) {
    XcdBarrier b; b.bar = bar; b.x = xb_xcc_id(); b.st = st;
    if (threadIdx.x == 0) (void)xb_add(&bar[XB_XCNT(b.x)], 1u);
    return b;
}
__device__ __forceinline__ void xcd_barrier_complete(unsigned* bar, unsigned x, unsigned& nloc, unsigned& nx) {
    const unsigned G = gridDim.x * gridDim.y * gridDim.z;
    unsigned sum, cnt, mine, sp = 0u;
    for (;;) {
        sum = 0u; cnt = 0u; mine = 0u;
#pragma unroll
        for (unsigned j = 0; j < 16; ++j) { const unsigned c = xb_ld(&bar[XB_XCNT(j)]); sum += c; cnt += (c > 0u) ? 1u : 0u; mine = (j == x) ? c : mine; }
        if (sum == G) break;
        __builtin_amdgcn_s_sleep(1);
        if ((++sp & 255u) == 0u) { if (xb_ld(&bar[XB_TMO])) break; if (sp > XB_SPIN_CAP) { atomicAdd(&bar[XB_TMO], 1u); break; } }
    }
    nloc = mine > 0u ? mine : 1u; nx = cnt > 0u ? cnt : 1u;
}

__device__ __forceinline__ void xcd_barrier(const XcdBarrier& b) {
    asm volatile("s_waitcnt vmcnt(0)" ::: "memory");
    __syncthreads();
    if (threadIdx.x == 0) {
        unsigned* bar = b.bar;
        __builtin_amdgcn_s_waitcnt(0);
        unsigned nloc = b.st[0], nx = b.st[1];
        if (nloc == 0u) { xcd_barrier_complete(bar, b.x, nloc, nx); b.st[0] = nloc; b.st[1] = nx; }
        const unsigned old = xb_add(&bar[XB_XSUB(b.x)], 1u);
        const unsigned gen = old / nloc;
        if (old + 1u == (gen + 1u) * nloc) {
            __builtin_amdgcn_fence(__ATOMIC_RELEASE, "agent");
            asm volatile("s_waitcnt vmcnt(0)" ::: "memory");
            const unsigned og = xb_add(&bar[XB_TOP], 1u);
            const unsigned tg = og / nx;
            if (og + 1u == (tg + 1u) * nx) xb_add(&bar[XB_TOPGEN], 1u);
            else XB_SPIN(xb_ld(&bar[XB_TOPGEN]) == tg, bar);
            __builtin_amdgcn_fence(__ATOMIC_ACQUIRE, "agent");
            xb_add(&bar[XB_XGEN(b.x)], 1u);
            asm volatile("s_waitcnt vmcnt(0)" ::: "memory");
        } else {
            XB_SPIN(xb_ld(&bar[XB_XGEN(b.x)]) == gen, bar);
            __builtin_amdgcn_fence(__ATOMIC_ACQUIRE, "agent");
            asm volatile("s_waitcnt vmcnt(0)" ::: "memory");
        }
    }
    __syncthreads();
}

#ifndef PROBE_DUP
#define PROBE_DUP 0
#endif

DI void nsa_prep_phase(KP p, int l, int lane, int gw, int NGW, bool dry = false) {
    bf16_t* P1 = (bf16_t*)(p->ws + OFF_P1);
    bf16_t* VsT = (bf16_t*)(p->ws + OFF_VT); bf16_t* VwT = VsT + (size_t)NB * 2 * 64 * S;
    const float wq = p->in[4][l * 64 + lane], wk = p->in[5][l * 64 + lane];
    const float inv = rope_inv_freq(lane & 31);
    for (int task = gw; task < M / 8; task += NGW) {
        const int tok0 = task * 8, b = tok0 / S, t0 = tok0 % S;
        unsigned vpk[4][4];
#pragma unroll
        for (int tt = 0; tt < 8; ++tt) {
            bf16_t* row = P1 + (size_t)(tok0 + tt) * LDP;
            float sn, cs; sincos_rad((float)(t0 + tt) * inv, &sn, &cs);
            if (lane < 32) sn = -sn;
#pragma unroll
            for (int h = 0; h < 8; ++h) {
                const float x = bf2f(row[C_Q + h * 64 + lane]);
                const float y = x * rsqrtf(wave_sum(x * x) * (1.f / 64.f) + EPS) * wq;
                const float pr = xor32f(y);
                if (!dry) row[C_Q + h * 64 + lane] = f2bf((y * cs + pr * sn) * (0.125f * 1.4426950408889634f));
            }
#pragma unroll
            for (int v = 0; v < 4; ++v) {
                const int col = ((v < 2) ? C_KS : C_KW) + (v & 1) * 64 + lane;
                const float x = bf2f(row[col]);
                const float y = x * rsqrtf(wave_sum(x * x) * (1.f / 64.f) + EPS) * wk;
                const float pr = xor32f(y);
                if (!dry) row[col] = f2bf(y * cs + pr * sn);
            }
#pragma unroll
            for (int v = 0; v < 4; ++v) {
                const unsigned val = row[((v < 2) ? C_VS : C_VW) + (v & 1) * 64 + lane];
                if (tt & 1) vpk[v][tt >> 1] |= val << 16; else vpk[v][tt >> 1] = val;
            }
        }
#pragma unroll
        for (int v = 0; v < 4; ++v) {
            bf16_t* dst = ((v < 2) ? VsT : VwT) + ((size_t)(b * 2 + (v & 1)) * 64 + lane) * S + t0;
            if (!dry) *(u32x4*)dst = (u32x4){vpk[v][0], vpk[v][1], vpk[v][2], vpk[v][3]};
        }
    }
}
DI void memkv_post_phase(KP p, int l, int wave, int lane, int bid, int nblk) {
    bf16_t* KV = (bf16_t*)(p->ws + SM_KVX); bf16_t* XVT = (bf16_t*)(p->ws + SM_XVT);
    const float w0 = p->in[30][l * 128 + lane], w1 = p->in[30][l * 128 + 64 + lane];
    for (int bt = bid; bt < 32; bt += nblk) {
        const int b = bt >> 4, h = (bt >> 2) & 3, key0 = (bt & 3) * 64 + wave * 8;
        unsigned v0[4], v1[4];
#pragma unroll
        for (int i = 0; i < 8; ++i) {
            const int tok = b * 256 + key0 + i;
            bf16_t* kr = KV + (size_t)tok * 1024 + h * 128;
            const float x0 = bf2f(kr[lane]), x1 = bf2f(kr[64 + lane]);
            const float r = rsqrtf(wave_sum(x0 * x0 + x1 * x1) * (1.f / 128.f) + EPS);
            kr[lane] = f2bf(x0 * r * w0); kr[64 + lane] = f2bf(x1 * r * w1);
            const bf16_t* vr = KV + (size_t)tok * 1024 + 512 + h * 128;
            const unsigned a0 = vr[lane], a1 = vr[64 + lane];
            if (i & 1) { v0[i >> 1] |= a0 << 16; v1[i >> 1] |= a1 << 16; } else { v0[i >> 1] = a0; v1[i >> 1] = a1; }
        }
        *(u32x4*)(XVT + ((size_t)(b * 4 + h) * 128 + lane) * 256 + key0) = (u32x4){v0[0], v0[1], v0[2], v0[3]};
        *(u32x4*)(XVT + ((size_t)(b * 4 + h) * 128 + 64 + lane) * 256 + key0) = (u32x4){v1[0], v1[1], v1[2], v1[3]};
    }
}
DI void nsa_compress_phase(KP p, int l, LAS unsigned char* lds, int wave, int lane, int gw, int NGW) {
    const bf16_t* P1 = (const bf16_t*)(p->ws + OFF_P1); const bf16_t* W = (const bf16_t*)(p->ws + OFF_W);
    bf16_t* Kc = (bf16_t*)(p->ws + SM_KC); bf16_t* VcT = (bf16_t*)(p->ws + SM_VCT); const float* cbv = (const float*)(p->ws + SM_CB);
    LAS bf16_t* Hl = (LAS bf16_t*)(lds + wave * 4096);
    const int r16 = lane & 15, quad = lane >> 4;
    for (int task = (gw >> 3) + (gw & 7) * (NGW >> 3); task < 512; task += NGW) {
        const int nt = task & 63, kv = (task >> 6) & 1, g = (task >> 7) & 1, b = task >> 8, n0 = nt * 16;
        const bf16_t* w1 = W + (kv ? WT_C1V : WT_C1K); const bf16_t* w2 = W + (kv ? WT_C2V : WT_C2K);
        const int col0 = (kv ? C_VC : C_KC) + g * 64;
        f32x4 acc[4];
#pragma unroll
        for (int i = 0; i < 4; ++i) acc[i] = (f32x4){0.f, 0.f, 0.f, 0.f};
        const int nrow = n0 + r16;
#pragma unroll 4
        for (int ks = 0; ks < 64; ++ks) {
            const int j = ks >> 1, d = (ks & 1) * 32 + quad * 8; int tok = 16 * nrow + j; if (tok > S - 1) tok = S - 1;
            const bf16x8 a = ldg8(P1 + (size_t)(b * S + tok) * LDP + col0 + d);
#pragma unroll
            for (int c = 0; c < 4; ++c) { const bf16x8 bb = ldg8(w1 + (size_t)(c * 16 + r16) * 2048 + ks * 32 + quad * 8); acc[c] = MFMA16(a, bb, acc[c]); }
        }
#pragma unroll
        for (int c = 0; c < 4; ++c) { const float bias = cbv[kv * 64 + c * 16 + r16];
#pragma unroll
            for (int j = 0; j < 4; ++j) Hl[(4 * quad + j) * 72 + c * 16 + r16] = f2bf(siluf(acc[c][j] + bias)); }
        f32x4 y[4];
#pragma unroll
        for (int i = 0; i < 4; ++i) y[i] = (f32x4){0.f, 0.f, 0.f, 0.f};
#pragma unroll
        for (int ks = 0; ks < 2; ++ks) { const bf16x8 a = lds8(Hl + r16 * 72 + ks * 32 + quad * 8);
#pragma unroll
            for (int c = 0; c < 4; ++c) { const bf16x8 bb = ldg8(w2 + (size_t)(c * 16 + r16) * 64 + ks * 32 + quad * 8); y[c] = MFMA16(a, bb, y[c]); } }
        if (kv == 0) {
            float ss[4];
#pragma unroll
            for (int j = 0; j < 4; ++j) { ss[j] = y[0][j] * y[0][j] + y[1][j] * y[1][j] + y[2][j] * y[2][j] + y[3][j] * y[3][j]; ss[j] = sum16(ss[j]); }
#pragma unroll
            for (int j = 0; j < 4; ++j) { const int n = n0 + 4 * quad + j; const float r = rsqrtf(ss[j] * (1.f / 64.f) + EPS);
#pragma unroll
                for (int c = 0; c < 2; ++c) { const int i = c * 16 + r16; const float inv = rope_inv_freq(i);
                    float sn, cs; sincos_rad((float)(16 * n + 31) * inv, &sn, &cs);
                    const float x1 = y[c][j] * r * p->in[5][l * 64 + i], x2 = y[c + 2][j] * r * p->in[5][l * 64 + 32 + i];
                    bf16_t* dst = Kc + ((size_t)(b * 2 + g) * 1024 + n) * 64;
                    const bool ok = n < 1023;
                    dst[i] = ok ? f2bf(x1 * cs - x2 * sn) : (bf16_t)0; dst[32 + i] = ok ? f2bf(x2 * cs + x1 * sn) : (bf16_t)0; } }
        } else {
#pragma unroll
            for (int c = 0; c < 4; ++c) { const int col = c * 16 + r16; const int nb4 = n0 + 4 * quad;
                u32x2 o; o.x = pk2(y[c][0], y[c][1]); o.y = pk2(y[c][2], (nb4 + 3 < 1023) ? y[c][3] : 0.f);
                *(u32x2*)(VcT + ((size_t)(b * 2 + g) * 64 + col) * 1024 + nb4) = o; }
        }
    }
}
template <int MODE, int PB, bool SB = false>
DI void nsa_stream(const bf16_t* kbase, size_t kpitch, const bf16_t* vbase, size_t vpitch, int blk0, int blk1,
                   LAS bf16_t* kvb, LAS bf16_t* Pl, const LAS unsigned* selm, LAS float* imp, int tid, int wave, int lane,
                   const bf16x8 (&qa)[2][2], const int (&tq)[2], const int (&nvq)[2], const float (&invc)[2][4], float mhat,
                   f32x4 (&acc)[2][4], float (&lsumv)[2][4]) {
    const int r16 = lane & 15, quad = lane >> 4, lkey = tid >> 3, lch = tid & 7;
    const int nb = blk1 - blk0 + 1;
    if (nb <= 0) return;
    const int nstep = (nb + PB - 1) / PB;
    const bf16_t* kg = kbase + (size_t)lkey * kpitch + lch * 8;
    const bf16_t* vg = vbase + (size_t)lkey * vpitch + lch * 8;
    bf16x8 kr[PB], vr[PB]; float lcol[2] = {0.f, 0.f};
#define NSA_STAGE_LOAD(step) { _Pragma("unroll") for (int bi = 0; bi < PB; ++bi) { int blk = blk0 + (step) * PB + bi; if (blk > blk1) blk = blk1; \
        kr[bi] = ldg8(kg + (size_t)blk * 64 * kpitch); if (MODE != 0) vr[bi] = ldg8(vg + blk * 64); } }
#define NSA_STAGE_WRITE(step) { LAS bf16_t* nb_ = kvb + (SB ? 0 : ((step) & 1) * (PB * 9216)); _Pragma("unroll") for (int bi = 0; bi < PB; ++bi) { \
        *(LAS bf16x8*)(nb_ + bi * 9216 + lkey * 72 + lch * 8) = kr[bi]; if (MODE != 0) *(LAS bf16x8*)(nb_ + bi * 9216 + 4608 + lkey * 72 + lch * 8) = vr[bi]; } }
    NSA_STAGE_LOAD(0);
    __syncthreads();
    NSA_STAGE_WRITE(0);
    if (nstep > 1) NSA_STAGE_LOAD(1);
    __syncthreads();
    for (int st = 0; st < nstep; ++st) {
        const LAS bf16_t* pb = kvb + (SB ? 0 : (st & 1) * (PB * 9216));
#pragma unroll
        for (int bi = 0; bi < PB; ++bi) {
            const int j = blk0 + st * PB + bi;
            if (j <= blk1) {
                const LAS bf16_t* Kl = pb + bi * 9216; const LAS bf16_t* Vl = Kl + 4608;
                bool nomask;
                if (MODE <= 1) nomask = (j * 64 + 63) < __builtin_amdgcn_readfirstlane(nvq[0]);
                else nomask = (j > blk0 || (MODE == 3)) && (j < blk1);
                bool bit[2] = {true, true};
                if (MODE == 3) {
#pragma unroll
                    for (int grp = 0; grp < 2; ++grp) { const unsigned w = selm[(wave * 8 + grp * 4 + (r16 >> 2)) * 8 + (j >> 5)]; bit[grp] = ((w >> (j & 31)) & 1u) != 0u; }
                }
                const bool act0 = (MODE != 3) || __builtin_amdgcn_ballot_w64(bit[0]) != 0ull, act1 = (MODE != 3) || __builtin_amdgcn_ballot_w64(bit[1]) != 0ull;
                if (act0 || act1) {
#pragma unroll
                    for (int kt = 0; kt < 4; ++kt) {
                        const int kp0 = j * 64 + kt * 16 + 4 * quad;
                        const LAS bf16_t* kp = Kl + (kt * 16 + r16) * 72 + quad * 8;
                        const bf16x8 kf0 = lds8(kp), kf1 = lds8(kp + 32);
#pragma unroll
                        for (int grp = 0; grp < 2; ++grp) if (grp == 0 ? act0 : act1) {
                            const float ci = (MODE == 3 && !bit[grp]) ? -1.0e30f : -mhat;
                            f32x4 s = (f32x4){ci, ci, ci, ci}; s = MFMA16(kf0, qa[grp][0], s); s = MFMA16(kf1, qa[grp][1], s);
                            float pj[4];
                            if (nomask) {
#pragma unroll
                                for (int jj = 0; jj < 4; ++jj) pj[jj] = __builtin_amdgcn_exp2f(s[jj]);
                            } else {
#pragma unroll
                                for (int jj = 0; jj < 4; ++jj) {
                                    const int kpos = kp0 + jj; bool vis;
                                    if (MODE <= 1) vis = kpos < nvq[grp];
                                    else if (MODE == 2) { const int dl = tq[grp] - kpos; vis = (dl >= 0) && (dl < 512); }
                                    else vis = bit[grp] && (kpos <= tq[grp]);
                                    pj[jj] = vis ? __builtin_amdgcn_exp2f(s[jj]) : 0.f;
                                }
                            }
                            if (MODE == 1) {
#pragma unroll
                                for (int jj = 0; jj < 4; ++jj) pj[jj] *= invc[grp][0];
                            }
                            if (MODE != 1) lcol[grp] += (pj[0] + pj[1]) + (pj[2] + pj[3]);
                            if (MODE != 0) *(LAS u32x2*)(Pl + (grp * 16 + r16) * 72 + kt * 16 + 4 * quad) = (u32x2){pk2(pj[0], pj[1]), pk2(pj[2], pj[3])};
                            if (MODE == 1) {
                                float v = 2.f * (pj[0] + pj[1] + pj[2]) + pj[3], sp = pj[3];
                                v = sum4(v); sp = sum4(sp);
                                if ((r16 & 3) == 0) {
                                    LAS float* ip = imp + (grp * 4 + (r16 >> 2)) * 256 + (kp0 >> 2);
                                    __hip_atomic_fetch_add(ip, v, __ATOMIC_RELAXED, __HIP_MEMORY_SCOPE_WORKGROUP);
                                    if ((kp0 >> 2) + 1 < 256) __hip_atomic_fetch_add(ip + 1, sp, __ATOMIC_RELAXED, __HIP_MEMORY_SCOPE_WORKGROUP);
                                }
                            }
                        }
                    }
                    if (MODE != 0) {
#pragma unroll
                        for (int ks = 0; ks < 2; ++ks) {
                            bf16x8 vf[4];
#pragma unroll
                            for (int dt = 0; dt < 4; ++dt) vf[dt] = lds8(Vl + (dt * 16 + r16) * 72 + ks * 32 + quad * 8);
                            if (act0) { const bf16x8 a0 = lds8(Pl + r16 * 72 + ks * 32 + quad * 8);
#pragma unroll
                                for (int dt = 0; dt < 4; ++dt) acc[0][dt] = MFMA16(a0, vf[dt], acc[0][dt]); }
                            if (act1) { const bf16x8 a1 = lds8(Pl + (16 + r16) * 72 + ks * 32 + quad * 8);
#pragma unroll
                                for (int dt = 0; dt < 4; ++dt) acc[1][dt] = MFMA16(a1, vf[dt], acc[1][dt]); }
                        }
                    }
                }
            }
        }
        if (SB) {
            __syncthreads();
            if (st + 1 < nstep) { NSA_STAGE_WRITE(st + 1); if (st + 2 < nstep) NSA_STAGE_LOAD(st + 2); }
            __syncthreads();
        } else {
            if (st + 1 < nstep) { NSA_STAGE_WRITE(st + 1); if (st + 2 < nstep) NSA_STAGE_LOAD(st + 2); }
            __syncthreads();
        }
    }
#undef NSA_STAGE_LOAD
#undef NSA_STAGE_WRITE
    if (MODE != 1) {
#pragma unroll
        for (int grp = 0; grp < 2; ++grp) { float t = lcol[grp]; t += xor16f(t); t += xor32f(t);
            if (MODE == 0) lsumv[grp][0] += t;
            else {
#pragma unroll
                for (int jj = 0; jj < 4; ++jj) { const float u = __shfl(t, 4 * quad + jj); lsumv[grp][jj] += (r16 == 0) ? u : 0.f; } } }
    }
}
DI void nsa_attn_phase(KP p, int l, LAS unsigned char* lds, int tid, int bid, int nblk, bool dry = false) {
    bf16_t* P1 = (bf16_t*)(p->ws + OFF_P1);
    const bf16_t* Kc = (const bf16_t*)(p->ws + SM_KC); const bf16_t* VcT = (const bf16_t*)(p->ws + SM_VCT);
    const bf16_t* VsT = (const bf16_t*)(p->ws + OFF_VT); const bf16_t* VwT = VsT + (size_t)NB * 2 * 64 * S;
    const int lane = tid & 63, wave = __builtin_amdgcn_readfirstlane(tid >> 6), r16 = lane & 15, quad = lane >> 4;
    LAS bf16_t* kvb = (LAS bf16_t*)lds;
    LAS bf16_t* Pl = (LAS bf16_t*)(lds + 73728 + wave * 4608);
    LAS unsigned* selm = (LAS unsigned*)(lds + 110592);
    LAS bf16_t* ocl = (LAS bf16_t*)(lds + 112640 + wave * 4096);
    LAS float* imp = (LAS float*)(wave < 4 ? lds + 36864 + wave * 8192 : lds + 112640 + (wave - 4) * 8192);
    const float mhat = 1.4426950408889634f * 8.0f * wave_max(fabsf(p->in[4][l * 64 + lane])) * wave_max(fabsf(p->in[5][l * 64 + lane]));
    for (int task = bid; task < 1024; task += nblk) {
        const int bg = task >> 8, r = task & 255, qt = (bg & 1) ? 255 - r : r, b = bg >> 1, g = bg & 1;
        const size_t rowb = (size_t)b * S; const int tb = qt * 64, t0 = tb + wave * 8;
        const bf16_t* kcb = Kc + (size_t)(b * 2 + g) * 1024 * 64; const bf16_t* vcb = VcT + (size_t)(b * 2 + g) * 64 * 1024;
        bf16x8 qa[2][2]; int tq[2], nvq[2];
#pragma unroll
        for (int grp = 0; grp < 2; ++grp) { const bf16_t* qp = P1 + (rowb + t0 + grp * 4 + (r16 >> 2)) * LDP + C_Q + (g * 4 + (r16 & 3)) * 64 + quad * 8; qa[grp][0] = ldg8(qp); qa[grp][1] = ldg8(qp + 32);
            tq[grp] = t0 + grp * 4 + (r16 >> 2); nvq[grp] = tq[grp] >= 31 ? ((tq[grp] - 31) >> 4) + 1 : 0; }
        const int tl = tb + 63; const int nvt = tl >= 31 ? ((tl - 31) >> 4) + 1 : 0;
        const int cblk1 = nvt > 0 ? ((nvt - 1) >> 6) : -1;
        f32x4 acc[2][4]; float lsv[2][4], invc[2][4];
#pragma unroll
        for (int grp = 0; grp < 2; ++grp)
#pragma unroll
            for (int i = 0; i < 4; ++i) { acc[grp][i] = (f32x4){0.f, 0.f, 0.f, 0.f}; lsv[grp][i] = 0.f; invc[grp][i] = 0.f; }
        nsa_stream<0, 1>(kcb, 64, vcb, 1024, 0, cblk1, kvb, Pl, selm, imp, tid, wave, lane, qa, tq, nvq, invc, mhat, acc, lsv);
#pragma unroll
        for (int grp = 0; grp < 2; ++grp) { const float t = lsv[grp][0]; invc[grp][0] = t > 0.f ? 1.0f / t : 0.f; lsv[grp][0] = 0.f; }
        for (int i = lane; i < 2048; i += 64) imp[i] = 0.f;
        nsa_stream<1, 1>(kcb, 64, vcb, 1024, 0, cblk1, kvb, Pl, selm, imp, tid, wave, lane, qa, tq, nvq, invc, mhat, acc, lsv);
        const int cur = qt;
        {
            const int nf = cur >= 2 ? 3 : (cur >= 1 ? 2 : 1);
            int need = cur - 2; if (need < 0) need = 0; if (need > 16 - nf) need = 16 - nf;
            for (int qi = 0; qi < 4; ++qi) {
                unsigned long long ka[4], kb[4];
#pragma unroll
                for (int i = 0; i < 4; ++i) { const int j = i * 64 + lane; const bool cand = (j >= 1) && (j <= cur - 2);
                    ka[i] = cand ? ((((unsigned long long)__float_as_uint(imp[qi * 256 + j])) << 8) | (unsigned long long)(255 - j)) : 0ull;
                    kb[i] = cand ? ((((unsigned long long)__float_as_uint(imp[(qi + 4) * 256 + j])) << 8) | (unsigned long long)(255 - j)) : 0ull; }
                unsigned long long Ta = 0ull, Tb = 0ull;
                if (need > 0) {
                    for (int bit = 39; bit >= 0; --bit) {
                        const unsigned long long ca = Ta | (1ull << bit), cb = Tb | (1ull << bit);
                        const int na = __builtin_popcountll(__builtin_amdgcn_ballot_w64(ka[0] >= ca)) + __builtin_popcountll(__builtin_amdgcn_ballot_w64(ka[1] >= ca))
                                     + __builtin_popcountll(__builtin_amdgcn_ballot_w64(ka[2] >= ca)) + __builtin_popcountll(__builtin_amdgcn_ballot_w64(ka[3] >= ca));
                        const int nb = __builtin_popcountll(__builtin_amdgcn_ballot_w64(kb[0] >= cb)) + __builtin_popcountll(__builtin_amdgcn_ballot_w64(kb[1] >= cb))
                                     + __builtin_popcountll(__builtin_amdgcn_ballot_w64(kb[2] >= cb)) + __builtin_popcountll(__builtin_amdgcn_ballot_w64(kb[3] >= cb));
                        if (na >= need) Ta = ca;
                        if (nb >= need) Tb = cb;
                    }
                }
#pragma unroll
                for (int half = 0; half < 2; ++half) {
                    unsigned long long mb[4];
#pragma unroll
                    for (int i = 0; i < 4; ++i) { const unsigned long long k = half ? kb[i] : ka[i]; const unsigned long long T = half ? Tb : Ta; mb[i] = (need > 0) ? __builtin_amdgcn_ballot_w64(k >= T && k != 0ull) : 0ull; }
                    if (lane == 0) {
                        unsigned wv[8];
#pragma unroll
                        for (int i = 0; i < 4; ++i) { wv[2 * i] = (unsigned)mb[i]; wv[2 * i + 1] = (unsigned)(mb[i] >> 32); }
                        wv[0] |= 1u;
#pragma unroll
                        for (int w = 0; w < 8; ++w) { if (w == (cur >> 5)) wv[w] |= 1u << (cur & 31); if (cur >= 1 && w == ((cur - 1) >> 5)) wv[w] |= 1u << ((cur - 1) & 31); selm[(wave * 8 + qi + 4 * half) * 8 + w] = wv[w]; }
                    }
                }
            }
        }
        __syncthreads();
#pragma unroll
        for (int grp = 0; grp < 2; ++grp) {
            const bf16_t* orow = P1 + (rowb + t0 + grp * 4 + quad) * LDP;
#pragma unroll
            for (int j = 0; j < 4; ++j) { const float g0 = sigmf(bf2f(orow[C_NG + (g * 4 + j) * 3 + 0]));
#pragma unroll
                for (int dt = 0; dt < 4; ++dt) { ocl[grp * 1024 + (4 * quad + j) * 64 + dt * 16 + r16] = f2bf(g0 * acc[grp][dt][j]); acc[grp][dt][j] = 0.f; } lsv[grp][j] = 0.f; }
        }
        nsa_stream<2, 2>(P1 + rowb * LDP + C_KW + g * 64, LDP, VwT + (size_t)(b * 2 + g) * 64 * S, S, qt >= 8 ? qt - 8 : 0, qt, kvb, Pl, selm, imp, tid, wave, lane, qa, tq, nvq, invc, mhat, acc, lsv);
#pragma unroll
        for (int grp = 0; grp < 2; ++grp) {
            const bf16_t* orow = P1 + (rowb + t0 + grp * 4 + quad) * LDP;
#pragma unroll
            for (int j = 0; j < 4; ++j) { const float tsum = sum16(lsv[grp][j]); const float gw2 = tsum > 0.f ? sigmf(bf2f(orow[C_NG + (g * 4 + j) * 3 + 2])) / tsum : 0.f;
#pragma unroll
                for (int dt = 0; dt < 4; ++dt) { LAS bf16_t* op = ocl + grp * 1024 + (4 * quad + j) * 64 + dt * 16 + r16; *op = f2bf(bf2f(*op) + gw2 * acc[grp][dt][j]); acc[grp][dt][j] = 0.f; } lsv[grp][j] = 0.f; }
        }
        if (!(dry && PROBE_DUP == 4))
        nsa_stream<3, 4, true>(P1 + rowb * LDP + C_KS + g * 64, LDP, VsT + (size_t)(b * 2 + g) * 64 * S, S, 0, qt, kvb, Pl, selm, imp, tid, wave, lane, qa, tq, nvq, invc, mhat, acc, lsv);
#pragma unroll
        for (int grp = 0; grp < 2; ++grp) {
            bf16_t* orow = P1 + (rowb + t0 + grp * 4 + quad) * LDP;
#pragma unroll
            for (int j = 0; j < 4; ++j) { const int hd = g * 4 + j; const float tsum = sum16(lsv[grp][j]); const float iv = tsum > 0.f ? sigmf(bf2f(orow[C_NG + hd * 3 + 1])) / tsum : 0.f;
#pragma unroll
                for (int dt = 0; dt < 4; ++dt) if (!dry) orow[C_Q + hd * 64 + dt * 16 + r16] = f2bf(bf2f(ocl[grp * 1024 + (4 * quad + j) * 64 + dt * 16 + r16]) + acc[grp][dt][j] * iv); }
        }
        __syncthreads();
    }
}
#ifndef SSD_NO_YOFF
#define SSD_NO_YOFF 0
#endif

DI void ssd_dt(KP p, int l, const bf16_t* P1, size_t tok0, int g, LAS float* dtl, LAS float* acl, int tid) {
    const int hg = tid >> 7, s = tid & 127, hh = g * 4 + hg, lane = tid & 63;
    const float A = -__expf(p->in[16][l * 8 + hh]);
    const float x = bf2f(P1[(tok0 + s) * LDP + C_DT + hh]) + p->in[15][l * 8 + hh];
    const float dt = x > 20.f ? x : __logf(1.0f + __expf(x));
    const float a = dt * A;
    float v = a;
#pragma unroll
    for (int o = 1; o < 64; o <<= 1) { const float u = __shfl_up(v, o); if (lane >= o) v += u; }
    dtl[hg * 128 + s] = dt;
    if ((s & 63) == 63 && s < 64) acl[hg * 128 + 127] = v;
    __syncthreads();
    const float add = (s >= 64) ? acl[hg * 128 + 127] : 0.f;
    __syncthreads();
    acl[hg * 128 + s] = v + add;
    __syncthreads();
}
DI void ssd_conv16(KP p, int l, const bf16_t* P1, size_t tok0, int tchunk0, int cc, int s0, float* out) {
    const float* cw = p->in[13] + (size_t)l * 4 * 768; const float w0 = cw[cc], w1 = cw[768 + cc], w2 = cw[2 * 768 + cc], w3 = cw[3 * 768 + cc];
    const float bias = p->in[14][l * 768 + cc];
    const bf16_t* col = P1 + C_XBC + cc;
    float h0 = 0.f, h1 = 0.f, h2 = 0.f;
    if (tchunk0 + s0 - 3 >= 0) h0 = bf2f(col[(tok0 + s0 - 3) * LDP]);
    if (tchunk0 + s0 - 2 >= 0) h1 = bf2f(col[(tok0 + s0 - 2) * LDP]);
    if (tchunk0 + s0 - 1 >= 0) h2 = bf2f(col[(tok0 + s0 - 1) * LDP]);
#pragma unroll
    for (int i = 0; i < 16; ++i) {
        const float xc = bf2f(col[(tok0 + s0 + i) * LDP]);
        out[i] = siluf(bias + w0 * h0 + w1 * h1 + w2 * h2 + w3 * xc);
        h0 = h1; h1 = h2; h2 = xc;
    }
}
DI void ssd_local_phase(KP p, int l, LAS unsigned char* lds, int tid, int nblk, int bid) {
    const bf16_t* P1 = (const bf16_t*)(p->ws + OFF_P1); bf16_t* SST = (bf16_t*)(p->ws + OFF_SST); float* cdec = (float*)(p->ws + SM_CDEC);
    LAS float* dtl = (LAS float*)lds; LAS float* acl = dtl + 512; LAS float* wl = acl + 512;
    LAS bf16_t* xT = (LAS bf16_t*)(lds + 8192);
    LAS bf16_t* BT = xT + 256 * 136;
    const int wave = tid >> 6, lane = tid & 63, r16 = lane & 15, quad = lane >> 4;
    for (int task = bid; task < NB * 128 * 2; task += nblk) {
        const int c = task & 127, b = (task >> 7) & 1, g = task >> 8;     const size_t tok0 = (size_t)b * S + c * 128;
        ssd_dt(p, l, P1, tok0, g, dtl, acl, tid);
        { const int hg = tid >> 7, s = tid & 127; const float al = acl[hg * 128 + 127]; wl[hg * 128 + s] = dtl[hg * 128 + s] * __expf(al - acl[hg * 128 + s]);
          if (s == 0) cdec[(b * 128 + c) * 32 + g * 4 + hg] = __expf(al); }
        __syncthreads();
        for (int it = tid; it < 320 * 8; it += 512) {
            const int ci = it % 320, seg = it / 320;
            float cv[16]; const int cc = (ci < 256) ? (g * 256 + ci) : (512 + g * 64 + ci - 256);
            ssd_conv16(p, l, P1, tok0, c * 128, cc, seg * 16, cv);
            if (ci < 256) { const int hg = ci >> 6;
#pragma unroll
                for (int i = 0; i < 16; ++i) xT[ci * 136 + seg * 16 + i] = f2bf(cv[i] * wl[hg * 128 + seg * 16 + i]); }
            else { const int n = ci - 256;
#pragma unroll
                for (int i = 0; i < 16; ++i) BT[n * 136 + seg * 16 + i] = f2bf(cv[i]); }
        }
        __syncthreads();
        { const int hg = wave >> 1, hh = g * 4 + hg;
#pragma unroll
          for (int pi = 0; pi < 2; ++pi) { const int pt = (wave & 1) * 2 + pi;
            f32x4 acc[4];
#pragma unroll
            for (int i = 0; i < 4; ++i) acc[i] = (f32x4){0.f, 0.f, 0.f, 0.f};
#pragma unroll
            for (int ks = 0; ks < 4; ++ks) { const bf16x8 a = lds8(xT + (hg * 64 + pt * 16 + r16) * 136 + ks * 32 + quad * 8);
#pragma unroll
                for (int nt = 0; nt < 4; ++nt) acc[nt] = MFMA16(a, lds8(BT + (nt * 16 + r16) * 136 + ks * 32 + quad * 8), acc[nt]); }
            bf16_t* dst = SST + ((size_t)((b * 128 + c) * 8 + hh) * 64) * 64;
#pragma unroll
            for (int nt = 0; nt < 4; ++nt)
#pragma unroll
                for (int j = 0; j < 4; ++j) dst[(pt * 16 + 4 * quad + j) * 64 + nt * 16 + r16] = f2bf(acc[nt][j]); } }
        __syncthreads();
    }
}
DI void ssd_scan_phase(KP p, int gtid, int nthr, bool dry = false) {
    bf16_t* SST = (bf16_t*)(p->ws + OFF_SST); const float* cdec = (const float*)(p->ws + SM_CDEC);
    for (int idx = gtid; idx < NB * 8 * 4096; idx += nthr) {
        const int b = idx >> 15, hh = (idx >> 12) & 7, pn = idx & 4095; float h = 0.f;
        for (int c0 = 0; c0 < 128; c0 += 16) {
            float st[16], dc[16];
#pragma unroll
            for (int i = 0; i < 16; ++i) { const size_t a = ((size_t)((b * 128 + c0 + i) * 8 + hh) << 12) + pn; st[i] = bf2f(SST[a]); dc[i] = __hip_atomic_load(cdec + (b * 128 + c0 + i) * 32 + hh, __ATOMIC_RELAXED, __HIP_MEMORY_SCOPE_AGENT); }
#pragma unroll
            for (int i = 0; i < 16; ++i) { const size_t a = ((size_t)((b * 128 + c0 + i) * 8 + hh) << 12) + pn; if (!dry) SST[a] = f2bf(h); h = h * dc[i] + st[i]; }
        }
    }
}
DI void ssd_out_phase(KP p, int l, LAS unsigned char* lds, int tid, int nblk, int bid, bool dry = false) {
    bf16_t* P1 = (bf16_t*)(p->ws + OFF_P1); const bf16_t* SST = (const bf16_t*)(p->ws + OFF_SST);
    LAS float* dtl = (LAS float*)lds; LAS float* acl = dtl + 512;
    LAS bf16_t* Cl = (LAS bf16_t*)(lds + 4096);
    LAS bf16_t* cbl = Cl + 128 * 72;
    LAS bf16_t* xT = cbl + 128 * 136;
    LAS bf16_t* Bl = xT + 64 * 136;
    const int wave = tid >> 6, lane = tid & 63, r16 = lane & 15, quad = lane >> 4;
    LAS bf16_t* yb_l = xT + 64 * 136 + wave * (16 * 264);
    for (int task = bid; task < NB * 128 * 2; task += nblk) {
        const int c = task & 127, b = (task >> 7) & 1, g = task >> 8;     const size_t tok0 = (size_t)b * S + c * 128;
        ssd_dt(p, l, P1, tok0, g, dtl, acl, tid);
        for (int it = tid; it < 128 * 8; it += 512) {
            const int ci = it & 127, seg = it >> 7;
            float cv[16]; const int cc = (ci < 64) ? (512 + g * 64 + ci) : (640 + g * 64 + ci - 64);
            ssd_conv16(p, l, P1, tok0, c * 128, cc, seg * 16, cv);
            LAS bf16_t* dstl = (ci < 64) ? (Bl + ci) : (Cl + ci - 64);
#pragma unroll
            for (int i = 0; i < 16; ++i) dstl[(seg * 16 + i) * 72] = f2bf(cv[i]);
        }
        __syncthreads();
        { f32x4 acc[8];
#pragma unroll
          for (int i = 0; i < 8; ++i) acc[i] = (f32x4){0.f, 0.f, 0.f, 0.f};
#pragma unroll
          for (int ks = 0; ks < 2; ++ks) { const bf16x8 a = lds8(Cl + (16 * wave + r16) * 72 + ks * 32 + quad * 8);
#pragma unroll
              for (int st = 0; st < 8; ++st) acc[st] = MFMA16(a, lds8(Bl + (st * 16 + r16) * 72 + ks * 32 + quad * 8), acc[st]); }
#pragma unroll
          for (int st = 0; st < 8; ++st)
#pragma unroll
              for (int j = 0; j < 4; ++j) cbl[(16 * wave + 4 * quad + j) * 136 + st * 16 + r16] = f2bf(acc[st][j]); }
        float ssq[4] = {0.f, 0.f, 0.f, 0.f};
        for (int hg = 0; hg < 4; ++hg) {
            const int hh = g * 4 + hg;
            __syncthreads();
            { const int ci = tid & 63, seg = tid >> 6; float cv[16]; ssd_conv16(p, l, P1, tok0, c * 128, hh * 64 + ci, seg * 16, cv);
#pragma unroll
              for (int i = 0; i < 16; ++i) xT[ci * 136 + seg * 16 + i] = f2bf(cv[i]); }
            __syncthreads();
            f32x4 yd[4], yo[4];
#pragma unroll
            for (int i = 0; i < 4; ++i) { yd[i] = (f32x4){0.f, 0.f, 0.f, 0.f}; yo[i] = (f32x4){0.f, 0.f, 0.f, 0.f}; }
            const int trow = 16 * wave + r16; const float at = acl[hg * 128 + trow];
            for (int ks = 0; ks * 32 <= 16 * wave + 15; ++ks) {
                float f[8]; const bf16x8 cbv = lds8(cbl + trow * 136 + ks * 32 + quad * 8); unpack8(cbv, f);
#pragma unroll
                for (int i = 0; i < 8; ++i) { const int s = ks * 32 + quad * 8 + i; f[i] = (s <= trow) ? f[i] * __expf(at - acl[hg * 128 + s]) * dtl[hg * 128 + s] : 0.f; }
                const bf16x8 a = pack8(f);
#pragma unroll
                for (int pt = 0; pt < 4; ++pt) yd[pt] = MFMA16(a, lds8(xT + (pt * 16 + r16) * 136 + ks * 32 + quad * 8), yd[pt]); }
            const bf16_t* prev = SST + ((size_t)((b * 128 + c) * 8 + hh) * 64) * 64;
#pragma unroll
            for (int ks = 0; ks < (SSD_NO_YOFF ? 0 : 2); ++ks) { const bf16x8 a = lds8(Cl + trow * 72 + ks * 32 + quad * 8);
#pragma unroll
                for (int pt = 0; pt < 4; ++pt) yo[pt] = MFMA16(a, ldg8(prev + (size_t)(pt * 16 + r16) * 64 + ks * 32 + quad * 8), yo[pt]); }
            const float dsk = p->in[17][l * 8 + hh];
#pragma unroll
            for (int j = 0; j < 4; ++j) { const int t = 16 * wave + 4 * quad + j; const float ea = __expf(acl[hg * 128 + t]);
#pragma unroll
                for (int pt = 0; pt < 4; ++pt) { const int pp = pt * 16 + r16;
                    const float y = yd[pt][j] + yo[pt][j] * ea + bf2f(xT[pp * 136 + t]) * dsk;
                    const float z = bf2f(P1[(tok0 + t) * LDP + C_Z + hh * 64 + pp]); const bf16_t yb = f2bf(y * siluf(z)); const float yr = bf2f(yb);
                    ssq[j] += yr * yr; yb_l[(4 * quad + j) * 264 + hg * 64 + pp] = yb; } }
        }
#pragma unroll
        for (int j = 0; j < 4; ++j) ssq[j] = rsqrtf(sum16(ssq[j]) * (1.f / 256.f) + EPS);
        for (int hg = 0; hg < 4; ++hg)
#pragma unroll
            for (int j = 0; j < 4; ++j)
#pragma unroll
                for (int pt = 0; pt < 4; ++pt) { const int t = 16 * wave + 4 * quad + j, col = (g * 4 + hg) * 64 + pt * 16 + r16;
                    if (!dry) P1[(tok0 + t) * LDP + C_Z + col] = f2bf(bf2f(yb_l[(4 * quad + j) * 264 + hg * 64 + pt * 16 + r16]) * ssq[j] * p->in[18][l * 512 + col]); }
        __syncthreads();
    }
}
DI float hg_lb(KP p, int l, int idx) { if (l == 0) return 0.f; const float l0 = p->in[20][idx], l1 = p->in[20][512 + idx]; return 1.0f / (1.0f + __expf(l0 - l1)); }
constexpr int BLP = 132;
DI void hg_cumlog(const bf16_t* P1, size_t tok0, int h, float lb, LAS float* bl, LAS float* segtot, int tid, float* fr) {
    const int d = tid & 127, sq = tid >> 7; float run = 0.f; float loc[16];
#pragma unroll
    for (int i = 0; i < 16; ++i) { fr[i] = bf2f(P1[(tok0 + sq * 16 + i) * LDP + C_HF + h * 128 + d]); run += __logf(lb + (1.f - lb) * sigmf(fr[i])); loc[i] = run; }
    segtot[sq * 128 + d] = run;
    __syncthreads();
    float off = 0.f;
#pragma unroll
    for (int q = 0; q < 3; ++q) if (q < sq) off += segtot[q * 128 + d];
#pragma unroll
    for (int i = 0; i < 16; ++i) bl[(sq * 16 + i) * BLP + d] = loc[i] + off;
    __syncthreads();
}
DI void hg_local_phase(KP p, int l, LAS unsigned char* lds, int tid, int nblk, int bid) {
    const bf16_t* P1 = (const bf16_t*)(p->ws + OFF_P1); bf16_t* HST = (bf16_t*)(p->ws + OFF_HST); float* hdec = (float*)(p->ws + SM_HDEC);
    LAS float* bl = (LAS float*)lds; LAS float* segtot = bl + 64 * BLP;
    LAS bf16_t* kdT = (LAS bf16_t*)(lds + 35840); LAS bf16_t* vT = kdT + 128 * 72;
    const int wave = tid >> 6, lane = tid & 63, r16 = lane & 15, quad = lane >> 4;
    for (int task = bid; task < NB * 4 * 256; task += nblk) {
        const int c = task & 255, h = (task >> 8) & 3, b = task >> 10; const size_t tok0 = (size_t)b * S + c * 64;
        const int d = tid & 127, sq = tid >> 7; const float lb = hg_lb(p, l, h * 128 + d);
        float fr[16]; hg_cumlog(P1, tok0, h, lb, bl, segtot, tid, fr);
        { const float blast = bl[63 * BLP + d]; float kd[16]; unsigned vv[8];
#pragma unroll
          for (int i = 0; i < 16; ++i) kd[i] = (1.f - lb) * sigmf(-fr[i]) * __expf(blast - bl[(sq * 16 + i) * BLP + d]);
#pragma unroll
          for (int i = 0; i < 8; ++i) { const unsigned a = P1[(tok0 + sq * 16 + 2 * i) * LDP + C_HI + h * 128 + d], bb = P1[(tok0 + sq * 16 + 2 * i + 1) * LDP + C_HI + h * 128 + d]; vv[i] = a | (bb << 16); }
          LAS u32x4* kd4 = (LAS u32x4*)(kdT + d * 72 + sq * 16); kd4[0] = (u32x4){pk2(kd[0], kd[1]), pk2(kd[2], kd[3]), pk2(kd[4], kd[5]), pk2(kd[6], kd[7])};
          kd4[1] = (u32x4){pk2(kd[8], kd[9]), pk2(kd[10], kd[11]), pk2(kd[12], kd[13]), pk2(kd[14], kd[15])};
          LAS u32x4* v4 = (LAS u32x4*)(vT + d * 72 + sq * 16); v4[0] = (u32x4){vv[0], vv[1], vv[2], vv[3]}; v4[1] = (u32x4){vv[4], vv[5], vv[6], vv[7]};
          if (sq == 0) hdec[((size_t)((b * 4 + h) * 256 + c)) * 128 + d] = __expf(blast); }
        __syncthreads();
        { f32x4 acc[8];
#pragma unroll
          for (int i = 0; i < 8; ++i) acc[i] = (f32x4){0.f, 0.f, 0.f, 0.f};
#pragma unroll
          for (int ks = 0; ks < 2; ++ks) { const bf16x8 a = lds8(vT + (16 * wave + r16) * 72 + ks * 32 + quad * 8);
#pragma unroll
              for (int dt = 0; dt < 8; ++dt) acc[dt] = MFMA16(a, lds8(kdT + (dt * 16 + r16) * 72 + ks * 32 + quad * 8), acc[dt]); }
          bf16_t* dst = HST + ((size_t)((b * 4 + h) * 256 + c) << 14);
#pragma unroll
          for (int dt = 0; dt < 8; ++dt)
#pragma unroll
              for (int j = 0; j < 4; ++j) dst[(16 * wave + 4 * quad + j) * 128 + dt * 16 + r16] = f2bf(acc[dt][j]); }
        __syncthreads();
    }
}
DI void hg_scan_phase(KP p, int gtid, int nthr, bool dry = false) {
    bf16_t* HST = (bf16_t*)(p->ws + OFF_HST); const float* hdec = (const float*)(p->ws + SM_HDEC);
    for (int idx = gtid; idx < NB * 4 * 16384; idx += nthr) {
        const int bh = idx >> 14, ed = idx & 16383, d = ed & 127; float h = 0.f;
        for (int c0 = 0; c0 < 256; c0 += 16) {
            float st[16], dc[16];
#pragma unroll
            for (int i = 0; i < 16; ++i) { const size_t a = ((size_t)(bh * 256 + c0 + i) << 14) + ed; st[i] = bf2f(HST[a]); dc[i] = __hip_atomic_load(hdec + (size_t)(bh * 256 + c0 + i) * 128 + d, __ATOMIC_RELAXED, __HIP_MEMORY_SCOPE_AGENT); }
#pragma unroll
            for (int i = 0; i < 16; ++i) { const size_t a = ((size_t)(bh * 256 + c0 + i) << 14) + ed; if (!dry) HST[a] = f2bf(h); h = h * dc[i] + st[i]; }
        }
    }
}
DI void hg_out_phase(KP p, int l, LAS unsigned char* lds, int tid, int nblk, int bid, bool dry = false) {
    bf16_t* P1 = (bf16_t*)(p->ws + OFF_P1); const bf16_t* HST = (const bf16_t*)(p->ws + OFF_HST);
    LAS float* bl = (LAS float*)lds; LAS float* segtot = bl + 64 * BLP;
    LAS bf16_t* vT = (LAS bf16_t*)(lds + 35840);
    LAS bf16_t* attl = (LAS bf16_t*)(lds + 54272);
    LAS float* ssl = (LAS float*)(lds + 72704);
    LAS float* lbl = ssl + 128;
    const int wave = tid >> 6, lane = tid & 63, r16 = lane & 15, quad = lane >> 4;
    for (int task = bid; task < NB * 4 * 256; task += nblk) {
        const int c = task & 255, h = (task >> 8) & 3, b = task >> 10; const size_t tok0 = (size_t)b * S + c * 64;
        const int d = tid & 127, sq = tid >> 7; const float lb = hg_lb(p, l, h * 128 + d);
        if (sq == 0) lbl[d] = lb;
        { unsigned vv[8];
#pragma unroll
          for (int i = 0; i < 8; ++i) { const unsigned a = P1[(tok0 + sq * 16 + 2 * i) * LDP + C_HI + h * 128 + d], bb = P1[(tok0 + sq * 16 + 2 * i + 1) * LDP + C_HI + h * 128 + d]; vv[i] = a | (bb << 16); }
          LAS u32x4* v4 = (LAS u32x4*)(vT + d * 72 + sq * 16); v4[0] = (u32x4){vv[0], vv[1], vv[2], vv[3]}; v4[1] = (u32x4){vv[4], vv[5], vv[6], vv[7]}; }
        float fr[16]; hg_cumlog(P1, tok0, h, lb, bl, segtot, tid, fr);
        const int I = wave & 3, eh = wave >> 2, trow = 16 * I + r16;
        f32x4 acc[4];
#pragma unroll
        for (int i = 0; i < 4; ++i) acc[i] = (f32x4){0.f, 0.f, 0.f, 0.f};
        f32x4 att[4];
#pragma unroll
        for (int i = 0; i < 4; ++i) att[i] = (f32x4){0.f, 0.f, 0.f, 0.f};
        const bf16_t* Sin = HST + ((size_t)((b * 4 + h) * 256 + c) << 14);
#pragma unroll
        for (int ks = 0; ks < 4; ++ks) {
            const int d0 = ks * 32 + quad * 8;
            float q[8], qi[8]; unpack8(ldg8(P1 + (tok0 + trow) * LDP + C_HQ + h * 128 + d0), q);
#pragma unroll
            for (int i = 0; i < 8; ++i) { const float qs = siluf(q[i]) * 0.08838834764831845f; const float bt = bl[trow * BLP + d0 + i]; const float br = I > 0 ? bl[(16 * I - 1) * BLP + d0 + i] : 0.f;
                q[i] = qs * __expf(bt); qi[i] = qs * __expf(bt - br); }
            const bf16x8 aq = pack8(q), aqi = pack8(qi);
#pragma unroll
            for (int et = 0; et < 4; ++et) acc[et] = MFMA16(aq, ldg8(Sin + (size_t)(eh * 64 + et * 16 + r16) * 128 + d0), acc[et]);
#pragma unroll
            for (int J = 0; J < 4; ++J) { if (J <= I) {
                const int srow = 16 * J + r16; float kf[8]; unpack8(ldg8(P1 + (tok0 + srow) * LDP + C_HF + h * 128 + d0), kf);
#pragma unroll
                for (int i = 0; i < 8; ++i) { const float br = I > 0 ? bl[(16 * I - 1) * BLP + d0 + i] : 0.f; const float ex = fminf(br - bl[srow * BLP + d0 + i], 60.f);
                    kf[i] = (1.f - lbl[d0 + i]) * sigmf(-kf[i]) * __expf(ex); }
                att[J] = MFMA16(aqi, pack8(kf), att[J]); } }
        }
        LAS bf16_t* al = attl + wave * 16 * 72;
#pragma unroll
        for (int J = 0; J < 4; ++J)
#pragma unroll
            for (int j = 0; j < 4; ++j) { float v = (J < I) ? att[J][j] : ((J == I && r16 <= 4 * quad + j) ? att[J][j] : 0.f); al[(4 * quad + j) * 72 + J * 16 + r16] = f2bf(v); }
#pragma unroll
        for (int ks = 0; ks < 2; ++ks) { if (ks * 32 <= 16 * I + 15) { const bf16x8 a = lds8(al + r16 * 72 + ks * 32 + quad * 8);
#pragma unroll
            for (int et = 0; et < 4; ++et) acc[et] = MFMA16(a, lds8(vT + (eh * 64 + et * 16 + r16) * 72 + ks * 32 + quad * 8), acc[et]); } }
#pragma unroll
        for (int j = 0; j < 4; ++j) { float s = acc[0][j] * acc[0][j] + acc[1][j] * acc[1][j] + acc[2][j] * acc[2][j] + acc[3][j] * acc[3][j]; s = sum16(s); if (r16 == 0) ssl[eh * 64 + 16 * I + 4 * quad + j] = s; }
        __syncthreads();
#pragma unroll
        for (int j = 0; j < 4; ++j) { const int t = 16 * I + 4 * quad + j; const float r = rsqrtf((ssl[t] + ssl[64 + t]) * (1.f / 128.f) + EPS);
#pragma unroll
            for (int et = 0; et < 4; ++et) { const int e = eh * 64 + et * 16 + r16; bf16_t* gp = P1 + (tok0 + t) * LDP + C_HG + h * 128 + e;
                const bf16_t ov = f2bf(acc[et][j] * r * p->in[21][l * 128 + e] * siluf(bf2f(*gp))); if (!dry) *gp = ov; } }
        __syncthreads();
    }
}
DI void xattn_phase(KP p, int l, LAS unsigned char* lds, int wave, int lane, int gw, int NGW, bool dry = false) {
    bf16_t* QX = (bf16_t*)(p->ws + OFF_P1); const bf16_t* KV = (const bf16_t*)(p->ws + SM_KVX); const bf16_t* XVT = (const bf16_t*)(p->ws + SM_XVT);
    LAS bf16_t* Pl = (LAS bf16_t*)(lds + wave * 8704);
    const int r16 = lane & 15, quad = lane >> 4;
    const float w0 = p->in[29][l * 128 + lane], w1 = p->in[29][l * 128 + 64 + lane], k0 = p->in[30][l * 128 + lane], k1 = p->in[30][l * 128 + 64 + lane];
    const float mhat = 11.32f * wave_max(fmaxf(fabsf(w0), fabsf(w1))) * wave_max(fmaxf(fabsf(k0), fabsf(k1)));
    for (int task = gw; task < (M / 16) * 4; task += NGW) {
        const int h = task & 3, tb = task >> 2; const size_t tok0 = (size_t)tb * 16; const int b = (int)(tok0 / S);
        bf16x8 qa[4]; float ss = 0.f; float qf[4][8];
#pragma unroll
        for (int ks = 0; ks < 4; ++ks) { unpack8(ldg8(QX + (tok0 + r16) * 512 + h * 128 + ks * 32 + quad * 8), qf[ks]);
#pragma unroll
            for (int i = 0; i < 8; ++i) ss += qf[ks][i] * qf[ks][i]; }
        ss += xor16f(ss); ss += xor32f(ss);
        const float r = rsqrtf(ss * (1.f / 128.f) + EPS) * 0.08838834764831845f;
#pragma unroll
        for (int ks = 0; ks < 4; ++ks) {
#pragma unroll
            for (int i = 0; i < 8; ++i) qf[ks][i] *= r * p->in[29][l * 128 + ks * 32 + quad * 8 + i];
            qa[ks] = pack8(qf[ks]); }
        float ls[4] = {0.f, 0.f, 0.f, 0.f};
        const bf16_t* kb = KV + (size_t)(b * 256) * 1024 + h * 128;
        for (int kt = 0; kt < 16; ++kt) {
            f32x4 s = (f32x4){0.f, 0.f, 0.f, 0.f};
#pragma unroll
            for (int ks = 0; ks < 4; ++ks) s = MFMA16(qa[ks], ldg8(kb + (size_t)(kt * 16 + r16) * 1024 + ks * 32 + quad * 8), s);
#pragma unroll
            for (int j = 0; j < 4; ++j) { const float pj = __expf(s[j] - mhat); ls[j] += pj; Pl[(4 * quad + j) * 264 + kt * 16 + r16] = f2bf(pj); }
        }
        f32x4 o[8];
#pragma unroll
        for (int i = 0; i < 8; ++i) o[i] = (f32x4){0.f, 0.f, 0.f, 0.f};
        const bf16_t* vb = XVT + (size_t)(b * 4 + h) * 128 * 256;
        for (int ks = 0; ks < 8; ++ks) { const bf16x8 a = lds8(Pl + r16 * 264 + ks * 32 + quad * 8);
#pragma unroll
            for (int dt = 0; dt < 8; ++dt) o[dt] = MFMA16(a, ldg8(vb + (size_t)(dt * 16 + r16) * 256 + ks * 32 + quad * 8), o[dt]); }
#pragma unroll
        for (int j = 0; j < 4; ++j) { const float iv = 1.0f / sum16(ls[j]);
#pragma unroll
            for (int dt = 0; dt < 8; ++dt) if (!dry) QX[(tok0 + 4 * quad + j) * 512 + h * 128 + dt * 16 + r16] = f2bf(o[dt][j] * iv); }
    }
}

constexpr int LDS_BYTES = 147456;
template <class Epi> DI void run_gemm(LAS unsigned char* lds, const bf16_t* A, int lda, const bf16_t* Bt, int ldb, int Mr, int N, int K, const Epi& E) {
    pg8::Gemm g{A, Bt, Mr, N, K, lda, ldb}; pg8::StaticOrder So; So.init(Mr, N, (int)gridDim.x, (int)blockIdx.x);
    pg8::gemm_phase<Epi, pg8::StaticOrder, true, true>(lds, g, So, E);
}
#ifndef NO_PREP
#define NO_PREP 0
#endif
#ifndef NO_NSA
#define NO_NSA 0
#endif
#ifndef NO_SSD
#define NO_SSD 0
#endif
#ifndef NO_HG
#define NO_HG 0
#endif
#ifndef NO_XA
#define NO_XA 0
#endif
#ifndef NO_SSD_MERGE
#define NO_SSD_MERGE 0
#endif
#ifndef FORCE_X1
#define FORCE_X1 0
#endif
#ifndef PROBE_DUP
#define PROBE_DUP 0
#endif
#define FIRST_X (NO_NSA ? (((NO_SSD && !FORCE_X1) || NO_SSD_MERGE) ? 2 : 1) : 0)
__global__ void __launch_bounds__(512, 2) mega_fwd(Params prm_unused) {
    extern __shared__ __attribute__((aligned(16))) unsigned char lds_raw[];
    LAS unsigned char* lds = (LAS unsigned char*)lds_raw;
    cg::grid_group grid = cg::this_grid();
    volatile LAS unsigned* xb_st = (volatile LAS unsigned*)(lds + LDS_BYTES - 16);
    if (threadIdx.x < 2) xb_st[threadIdx.x] = 0u;
    __syncthreads();
    const XcdBarrier xbar = xcd_barrier_post((unsigned*)(((KP)__builtin_amdgcn_kernarg_segment_ptr())->ws + SM_BAR), xb_st);
    bool first_sync = true;
#define GSYNC() do { if (first_sync) { grid.sync(); first_sync = false; } else xcd_barrier(xbar); } while (0)
    const KP kp = (KP)__builtin_amdgcn_kernarg_segment_ptr();
    const int G = gridDim.x, bid = blockIdx.x, NGW = G * 8, nthr = G * 512;
#define FRESH() KP p = kp; asm volatile("" : "+s"(p)); int tid = threadIdx.x; asm volatile("" : "+v"(tid)); \
    const int lane = tid & 63, wave = __builtin_amdgcn_readfirstlane(tid >> 6), gw = bid * 8 + wave, gtid = bid * 512 + tid; (void)lane; (void)wave; (void)gw; (void)gtid; \
    bf16_t* W = (bf16_t*)(p->ws + OFF_W); bf16_t* H = (bf16_t*)(p->ws + OFF_H); bf16_t* P1 = (bf16_t*)(p->ws + OFF_P1); bf16_t* MG = (bf16_t*)(p->ws + OFF_HST); (void)W; (void)H; (void)P1; (void)MG;
#pragma unroll
    for (int l = 0; l < DEPTH; ++l) {
#if !NO_PREP
        { FRESH(); prep_phase(p, l, lds, wave, lane, gw, NGW); }
#endif
#if PROBE_DUP == 6
        { FRESH(); prep_phase(p, l, lds, wave, lane, gw, NGW); }
#endif
        GSYNC();
        { FRESH(); run_gemm(lds, H, 1024, W + WT_IN, 1024, M, NIN1, 1024, pg8::EpiStore<0>{P1, LDP, NP1}); }
#if PROBE_DUP == 7
        { FRESH(); run_gemm(lds, H, 1024, W + WT_IN, 1024, M, NIN1, 1024, pg8::EpiStore<0>{P1, LDP, NP1}); }
#endif
        { FRESH(); run_gemm(lds, (const bf16_t*)(p->ws + SM_MN), 1024, W + WT_XKV, 1024, 512, 1024, 1024, pg8::EpiStore<0>{(bf16_t*)(p->ws + SM_KVX), 1024, 1024}); }
        GSYNC();
#if PROBE_DUP == 8
        { FRESH(); nsa_prep_phase(p, l, lane, gw, NGW, p->out != nullptr); }
#endif
#if !NO_NSA
        { FRESH(); nsa_prep_phase(p, l, lane, gw, NGW); }
#endif
#if !NO_XA
        { FRESH(); memkv_post_phase(p, l, wave, lane, bid, G); }
#endif
#if !NO_SSD
        { FRESH(); ssd_local_phase(p, l, lds, tid, G, bid); }
#endif
#if !NO_HG
        { FRESH(); hg_local_phase(p, l, lds, tid, G, bid); }
#endif
#if PROBE_DUP == 6
        { FRESH(); ssd_local_phase(p, l, lds, tid, G, bid); }
        { FRESH(); hg_local_phase(p, l, lds, tid, G, bid); }
#endif
        GSYNC();
#if !NO_NSA
        { FRESH(); nsa_compress_phase(p, l, lds, wave, lane, gw, NGW); }
#endif
#if PROBE_DUP == 6
        { FRESH(); nsa_compress_phase(p, l, lds, wave, lane, gw, NGW); }
#endif
#if PROBE_DUP == 8
        { FRESH(); ssd_scan_phase(p, gtid, nthr, p->out != nullptr); }
        { FRESH(); hg_scan_phase(p, gtid, nthr, p->out != nullptr); }
#endif
#if !NO_SSD
        { FRESH(); ssd_scan_phase(p, gtid, nthr); }
#endif
#if !NO_HG
        { FRESH(); hg_scan_phase(p, gtid, nthr); }
#endif
        GSYNC();
#if PROBE_DUP == 2
        { FRESH(); ssd_out_phase(p, l, lds, tid, G, bid, p->out != nullptr); }
        { FRESH(); hg_out_phase(p, l, lds, tid, G, bid, p->out != nullptr); }
#endif
#if PROBE_DUP == 1 || PROBE_DUP == 4
        { FRESH(); nsa_attn_phase(p, l, lds, tid, bid, G, p->out != nullptr); }
#endif
#if PROBE_DUP == 3
        { FRESH(); nsa_compress_phase(p, l, lds, wave, lane, gw, NGW); }
        { FRESH(); ssd_local_phase(p, l, lds, tid, G, bid); }
        { FRESH(); hg_local_phase(p, l, lds, tid, G, bid); }
        { FRESH(); prep_phase(p, l, lds, wave, lane, gw, NGW); }
#endif
#if !NO_SSD
        { FRESH(); ssd_out_phase(p, l, lds, tid, G, bid); }
#endif
#if !NO_HG
        { FRESH(); hg_out_phase(p, l, lds, tid, G, bid); }
#endif
#if !NO_NSA
        { FRESH(); nsa_attn_phase(p, l, lds, tid, bid, G); }
#endif
        GSYNC();
        { FRESH(); run_gemm(lds, H, 1024, W + WT_G, 1024, M, 2048, 1024, pg8::EpiStore<1>{P1 + C_SG, LDP, 2048}); }
#if PROBE_DUP == 7
        { FRESH(); run_gemm(lds, H, 1024, W + WT_G, 1024, M, 2048, 1024, pg8::EpiStore<1>{P1 + C_SG, LDP, 2048}); }
#endif
        { FRESH(); run_gemm(lds, H, 1024, W + WT_G + (size_t)2048 * 1024, 1024, M, 1024, 1024, pg8::EpiStore<1>{MG, 1024, 1024}); }
#if PROBE_DUP == 7
        { FRESH(); run_gemm(lds, H, 1024, W + WT_G + (size_t)2048 * 1024, 1024, M, 1024, 1024, pg8::EpiStore<1>{MG, 1024, 1024}); }
#endif
        GSYNC();
        { FRESH(); run_gemm(lds, P1 + C_Q, LDP, W + WT_NSAO, 512, M, 1024, 512, pg8::EpiMerge{P1 + C_SG, LDP, P1 + C_SG, LDP, 0}); }
        asm volatile("s_waitcnt vmcnt(0)" ::: "memory"); __builtin_amdgcn_fence(__ATOMIC_ACQUIRE, "agent"); __syncthreads();
        { FRESH(); run_gemm(lds, P1 + C_Z, LDP, W + WT_SSMO, 512, M, 1024, 512, pg8::EpiMerge{P1 + C_SG + 1024, LDP, P1 + C_SG, LDP, 1}); }
        asm volatile("s_waitcnt vmcnt(0)" ::: "memory"); __builtin_amdgcn_fence(__ATOMIC_ACQUIRE, "agent"); __syncthreads();
        { FRESH(); run_gemm(lds, P1 + C_HG, LDP, W + WT_HGO, 512, M, 1024, 512, pg8::EpiMerge{MG, 1024, P1 + C_SG, LDP, 1}); }
        GSYNC();
        { FRESH(); run_gemm(lds, P1 + C_SG, LDP, W + WT_OUT, 1024, M, 1024, 1024, pg8::EpiResid{(l == 0) ? p->in[0] : p->out, p->out, 1024}); }
        GSYNC();
        { FRESH(); rms_phase(p->out, p->in[24] + (size_t)l * 1024, H, M, gw, NGW, lane); }
#if PROBE_DUP == 6
        { FRESH(); rms_phase(p->out, p->in[24] + (size_t)l * 1024, H, M, gw, NGW, lane); }
#endif
        GSYNC();
        { FRESH(); run_gemm(lds, H, 1024, W + WT_XQ, 1024, M, 512, 1024, pg8::EpiStore<0>{P1, 512, 512}); }
#if PROBE_DUP == 7
        { FRESH(); run_gemm(lds, H, 1024, W + WT_XQ, 1024, M, 512, 1024, pg8::EpiStore<0>{P1, 512, 512}); }
#endif
        GSYNC();
#if PROBE_DUP == 8
        { FRESH(); xattn_phase(p, l, lds, wave, lane, gw, NGW, p->out != nullptr); }
#endif
#if !NO_XA
        { FRESH(); xattn_phase(p, l, lds, wave, lane, gw, NGW); }
#endif
        GSYNC();
        { FRESH(); run_gemm(lds, P1, 512, W + WT_XO, 512, M, 1024, 512, pg8::EpiResid{p->out, p->out, 1024}); }
        GSYNC();
        { FRESH(); rms_phase(p->out, p->in[32] + (size_t)l * 1024, H, M, gw, NGW, lane); }
#if PROBE_DUP == 6
        { FRESH(); rms_phase(p->out, p->in[32] + (size_t)l * 1024, H, M, gw, NGW, lane); }
#endif
        GSYNC();
        { FRESH(); run_gemm(lds, H, 1024, W + WT_GU, 1024, M, 2 * FFH, 1024, pg8::EpiSwiglu{P1, FFH}); }
#if PROBE_DUP == 7
        { FRESH(); run_gemm(lds, H, 1024, W + WT_GU, 1024, M, 2 * FFH, 1024, pg8::EpiSwiglu{P1, FFH}); }
#endif
        GSYNC();
        { FRESH(); run_gemm(lds, P1, FFH, W + WT_DN, FFH, M, 1024, FFH, pg8::EpiResid{p->out, p->out, 1024}); }
        GSYNC();
    }
}

extern "C" void kernel_launch(void* const* d_in, const int* in_sizes, int n_in, void* d_out, int out_size, void* d_ws, size_t ws_size, hipStream_t stream) {
    static int grid = 0;
    if (grid == 0) {
        if (n_in != 36 || out_size != M * Dm || ws_size < WS_END) { fprintf(stderr, "kernel_launch: unexpected shapes: n_in %d out %d ws %zu (need %zu)\n", n_in, out_size, ws_size, (size_t)WS_END); grid = -1; return; }
        int dev = 0, cus = 0, per_cu = 0;
        hipGetDevice(&dev); hipDeviceGetAttribute(&cus, hipDeviceAttributeMultiprocessorCount, dev);
        if (hipFuncSetAttribute((const void*)mega_fwd, hipFuncAttributeMaxDynamicSharedMemorySize, LDS_BYTES) != hipSuccess) { fprintf(stderr, "kernel_launch: hipFuncSetAttribute failed\n"); grid = -1; return; }
        if (hipOccupancyMaxActiveBlocksPerMultiprocessor(&per_cu, (const void*)mega_fwd, 512, LDS_BYTES) != hipSuccess || per_cu < 1) { fprintf(stderr, "kernel_launch: occupancy query gave %d\n", per_cu); per_cu = 1; }
        (void)hipGetLastError();
        grid = cus * 1;
    }
    if (grid < 0) return;
    if (hipMemsetAsync((char*)d_ws + SM_BAR, 0, XCD_BAR_WORDS * 4, stream) != hipSuccess) { fprintf(stderr, "kernel_launch: memset of barrier words failed\n"); return; }
    Params prm{};
    for (int i = 0; i < 36; ++i) prm.in[i] = (const float*)d_in[i];
    prm.out = (float*)d_out; prm.ws = (unsigned char*)d_ws;
    void* args[] = {&prm};
    hipError_t e = hipLaunchCooperativeKernel((const void*)mega_fwd, dim3(grid), dim3(512), args, LDS_BYTES, stream);
    if (e != hipSuccess) fprintf(stderr, "cooperative launch failed: %s (grid %d)\n", hipGetErrorString(e), grid);
}
```
